# Optimizing an MI355X kernel written in HIP

```python
import math
import jax, jax.numpy as jnp
from jax import lax
import numpy as np

D_MODEL = 1024
BATCH = 8
SEQ = 4096
DEPTH = 1

D_FF = 2816
RMS_EPS = 1e-6
N_DIR = 2
D_HYENA = 512
HYENA_ORDER = 2
HYENA_BANDS = 16
HYENA_EMB = 2 * HYENA_BANDS + 1
HYENA_FFN = 64
HYENA_MIN_DECAY = abs(math.log(1e-2)) / 1.5
HYENA_MAX_DECAY = abs(math.log(1e-2)) / 0.3
FILTER_EPS = 1e-6
D_RWKV = 512
RWKV_HEAD = 64
RWKV_HEADS = D_RWKV // RWKV_HEAD
DECAY_LORA = 64
AAA_LORA = 64
GATE_LORA = 160
GN_EPS = 64e-5
N_HY_IN = 3 * D_HYENA
N_RW_IN = 3 * D_RWKV + N_DIR * (DECAY_LORA + AAA_LORA) + GATE_LORA
N_GATE = 2 * D_MODEL
N_IN = N_HY_IN + N_RW_IN + N_GATE

kernel_name = "hybrid_hyena_rwkv7_macaron_encoder"


def _rmsnorm(x, g):
    xf = x.astype(jnp.float32)
    y = xf * lax.rsqrt(jnp.mean(xf * xf, axis=-1, keepdims=True) + RMS_EPS)
    return (y * g.astype(jnp.float32)).astype(x.dtype)


def _swiglu(h, w_gu, w_down):
    gate, up = jnp.split(h @ w_gu, 2, axis=-1)
    return (jax.nn.silu(gate) * up) @ w_down


def _centred_conv3(u, w, b):
    up = jnp.pad(u, ((0, 0), (1, 1), (0, 0)))
    return w[0] * up[:, :-2] + w[1] * up[:, 1:-1] + w[2] * up[:, 2:] + b


def _centred_token_shift(u, mu):
    prev = jnp.pad(u, ((0, 0), (1, 0), (0, 0)))[:, :-1]
    nxt = jnp.pad(u, ((0, 0), (0, 1), (0, 0)))[:, 1:]
    return u + mu[0] * (prev - u) + mu[1] * (nxt - u)


def _hyena_filters(L, w1, b1, w2, b2, w3, b3, freq, decay):
    f32 = jnp.float32
    pos = jnp.arange(L, dtype=f32)
    t = (pos / max(L - 1, 1))[:, None]
    ang = (2.0 * math.pi / L) * pos[:, None]
    bands = jnp.linspace(1e-4, HYENA_BANDS - 1, HYENA_BANDS, dtype=f32)[None, :]
    feats = jnp.concatenate([t, jnp.cos(bands * ang), -jnp.sin(bands * ang)], axis=-1)
    fr = freq.astype(f32)
    h = jnp.sin(fr * (feats @ w1.astype(f32) + b1.astype(f32)))
    h = jnp.sin(fr * (h @ w2.astype(f32) + b2.astype(f32)))
    h = h @ w3.astype(f32) + b3.astype(f32)
    h = h.reshape(L, N_DIR, HYENA_ORDER, D_HYENA)
    h = h * jnp.exp(-t[:, :, None, None] * jnp.abs(decay.astype(f32))[None])
    fwd, bwd = h[:, 0], h[:, 1]
    zero = jnp.zeros((1, HYENA_ORDER, D_HYENA), f32)
    k = jnp.concatenate([fwd, zero, jnp.flip(bwd[1:], axis=0)], axis=0)
    k = k * lax.rsqrt(jnp.sum(k * k, axis=0, keepdims=True) + FILTER_EPS)
    return k


def _long_conv(z, k_f, d, L):
    zf = jnp.fft.rfft(z, n=2 * L, axis=1)
    y = jnp.fft.irfft(zf * k_f[None], n=2 * L, axis=1)[:, :L]
    return y + d * z


def _hyena_branch(u, conv_w, conv_b, w1, b1, w2, b2, w3, b3, freq, decay, bias_d, w_o):
    out_dtype = u.dtype
    L = u.shape[1]
    uc = _centred_conv3(u, conv_w, conv_b).astype(jnp.float32)
    x1, x2, v = jnp.split(uc, 3, axis=-1)
    k = _hyena_filters(L, w1, b1, w2, b2, w3, b3, freq, decay)
    k_f = jnp.fft.rfft(k, axis=0)
    d = bias_d.astype(jnp.float32)
    z = x1 * _long_conv(v, k_f[:, 0], d[0], L)
    z = x2 * _long_conv(z, k_f[:, 1], d[1], L)
    return z.astype(out_dtype) @ w_o


def _time_major_pair(fwd, bwd):
    return jnp.moveaxis(jnp.stack([fwd, jnp.flip(bwd, axis=1)], axis=0), 2, 0)


def _rwkv7_step(S, inp):
    r, w, k, v, kk, a = inp
    sa = jnp.einsum('dbhij,dbhj->dbhi', S, -kk)
    S = S * w[..., None, :] + sa[..., None] * (kk * a)[..., None, :] + v[..., None] * k[..., None, :]
    y = jnp.einsum('dbhij,dbhj->dbhi', S, r)
    return S, y


def _rwkv7_branch(u, mu, w0, w2, a0, a2, g2, k_k, k_a, r_k, ln_w, ln_b, w_o):
    out_dtype = u.dtype
    B, L, _ = u.shape
    H, N = RWKV_HEADS, RWKV_HEAD
    f32 = jnp.float32
    u = _centred_token_shift(u, mu).astype(f32)
    splits = [D_RWKV, 2 * D_RWKV, 3 * D_RWKV, 3 * D_RWKV + N_DIR * DECAY_LORA,
              3 * D_RWKV + N_DIR * (DECAY_LORA + AAA_LORA)]
    r, k, v, wd, ad, gd = jnp.split(u, splits, axis=-1)
    wd = wd.reshape(B, L, N_DIR, DECAY_LORA)
    ad = ad.reshape(B, L, N_DIR, AAA_LORA)
    w = -jax.nn.softplus(-(w0 + jnp.einsum('bldr,drc->bldc', jnp.tanh(wd), w2))) - 0.5
    decay = jnp.exp(-jnp.exp(w))
    a = jax.nn.sigmoid(a0 + jnp.einsum('bldr,drc->bldc', ad, a2))
    g = jax.nn.sigmoid(gd) @ g2
    kk = (k * k_k).reshape(B, L, H, N)
    kk = kk / jnp.maximum(jnp.sqrt(jnp.sum(kk * kk, axis=-1, keepdims=True)), 1e-12)
    k_dir = k[:, :, None, :] * (1.0 + (a - 1.0) * k_a)

    def heads(t):
        return t.reshape(t.shape[:-1] + (H, N))

    r_h, v_h = heads(r), heads(v)
    decay_h, a_h, k_h = heads(decay), heads(a), heads(k_dir)
    seq = (_time_major_pair(r_h, r_h),
           _time_major_pair(decay_h[:, :, 0], decay_h[:, :, 1]),
           _time_major_pair(k_h[:, :, 0], k_h[:, :, 1]),
           _time_major_pair(v_h, v_h),
           _time_major_pair(kk, kk),
           _time_major_pair(a_h[:, :, 0], a_h[:, :, 1]))
    S0 = jnp.zeros((N_DIR, B, H, N, N), f32)
    _, ys = lax.scan(_rwkv7_step, S0, seq)
    y = jnp.moveaxis(ys[:, 0] + jnp.flip(ys[:, 1], axis=0), 0, 1)
    mean = jnp.mean(y, axis=-1, keepdims=True)
    var = jnp.mean(jnp.square(y - mean), axis=-1, keepdims=True)
    y = ((y - mean) * lax.rsqrt(var + GN_EPS)).reshape(B, L, D_RWKV) * ln_w + ln_b
    bonus = jnp.sum(r_h[:, :, None] * k_h * r_k, axis=-1, keepdims=True)
    y = y + (jnp.sum(bonus, axis=2) * v_h).reshape(B, L, D_RWKV)
    y = y * g
    return y.astype(out_dtype) @ w_o


def setup_inputs(seed: int = 0) -> dict:
    key = jax.random.key(seed)
    ks = jax.random.split(key, 35)
    f32 = jnp.float32

    def nrm(i, shape, scale):
        return scale * jax.random.normal(ks[i], shape, f32)

    hy_decay_base = jnp.linspace(HYENA_MIN_DECAY, HYENA_MAX_DECAY, D_HYENA, dtype=f32)
    rw_w0_base = jnp.linspace(-6.0, -1.0, D_RWKV, dtype=f32)
    return {
        "x": nrm(0, (BATCH, SEQ, D_MODEL), 1.0),
        "ffn1_norm": 1.0 + nrm(1, (D_MODEL,), 0.05),
        "ffn1_w_gu": nrm(2, (D_MODEL, 2 * D_FF), D_MODEL ** -0.5),
        "ffn1_w_down": nrm(3, (D_FF, D_MODEL), D_FF ** -0.5),
        "mix_norm": 1.0 + nrm(4, (D_MODEL,), 0.05),
        "w_in": nrm(5, (D_MODEL, N_IN), D_MODEL ** -0.5),
        "hy_conv_w": nrm(6, (3, N_HY_IN), 3 ** -0.5),
        "hy_conv_b": nrm(7, (N_HY_IN,), 0.02),
        "hy_ffn_w1": nrm(8, (HYENA_EMB, HYENA_FFN), HYENA_EMB ** -0.5),
        "hy_ffn_b1": nrm(9, (HYENA_FFN,), 0.1),
        "hy_ffn_w2": nrm(10, (HYENA_FFN, HYENA_FFN), HYENA_FFN ** -0.5),
        "hy_ffn_b2": nrm(11, (HYENA_FFN,), 0.1),
        "hy_ffn_w3": nrm(12, (HYENA_FFN, N_DIR * HYENA_ORDER * D_HYENA), HYENA_FFN ** -0.5),
        "hy_ffn_b3": nrm(13, (N_DIR * HYENA_ORDER * D_HYENA,), 0.1),
        "hy_sin_freq": 1.0 + nrm(14, (HYENA_FFN,), 0.1),
        "hy_decay": hy_decay_base + nrm(15, (N_DIR, HYENA_ORDER, D_HYENA), 0.1),
        "hy_bias_d": nrm(16, (HYENA_ORDER, D_HYENA), 0.5),
        "hy_out": nrm(17, (D_HYENA, D_MODEL), D_HYENA ** -0.5),
        "rw_mu": jax.random.uniform(ks[18], (2, N_RW_IN), f32, 0.0, 0.5),
        "rw_w0": rw_w0_base + nrm(19, (N_DIR, D_RWKV), 0.1),
        "rw_w2": nrm(20, (N_DIR, DECAY_LORA, D_RWKV), 0.1),
        "rw_a0": nrm(21, (N_DIR, D_RWKV), 0.3),
        "rw_a2": nrm(22, (N_DIR, AAA_LORA, D_RWKV), 0.1),
        "rw_g2": nrm(23, (GATE_LORA, D_RWKV), GATE_LORA ** -0.5),
        "rw_k_k": 0.85 + nrm(24, (D_RWKV,), 0.05),
        "rw_k_a": 1.0 + nrm(25, (D_RWKV,), 0.05),
        "rw_r_k": nrm(26, (RWKV_HEADS, RWKV_HEAD), 0.1),
        "rw_ln_w": 1.0 + nrm(27, (D_RWKV,), 0.05),
        "rw_ln_b": nrm(28, (D_RWKV,), 0.02),
        "rw_out": nrm(29, (D_RWKV, D_MODEL), D_RWKV ** -0.5),
        "w_out": nrm(30, (D_MODEL, D_MODEL), D_MODEL ** -0.5),
        "ffn2_norm": 1.0 + nrm(31, (D_MODEL,), 0.05),
        "ffn2_w_gu": nrm(32, (D_MODEL, 2 * D_FF), D_MODEL ** -0.5),
        "ffn2_w_down": nrm(33, (D_FF, D_MODEL), D_FF ** -0.5),
        "final_norm": 1.0 + nrm(34, (D_MODEL,), 0.05),
    }


def reference(x, ffn1_norm, ffn1_w_gu, ffn1_w_down, mix_norm, w_in, hy_conv_w, hy_conv_b,
              hy_ffn_w1, hy_ffn_b1, hy_ffn_w2, hy_ffn_b2, hy_ffn_w3, hy_ffn_b3, hy_sin_freq,
              hy_decay, hy_bias_d, hy_out, rw_mu, rw_w0, rw_w2, rw_a0, rw_a2, rw_g2, rw_k_k,
              rw_k_a, rw_r_k, rw_ln_w, rw_ln_b, rw_out, w_out, ffn2_norm, ffn2_w_gu,
              ffn2_w_down, final_norm):
    split_at = [N_HY_IN, N_HY_IN + N_RW_IN, N_HY_IN + N_RW_IN + D_MODEL]
    for _ in range(DEPTH):
        x = x + 0.5 * _swiglu(_rmsnorm(x, ffn1_norm), ffn1_w_gu, ffn1_w_down)
        h = _rmsnorm(x, mix_norm)
        u_hy, u_rw, g_hy, g_rw = jnp.split(h @ w_in, split_at, axis=-1)
        y_hy = _hyena_branch(u_hy, hy_conv_w, hy_conv_b, hy_ffn_w1, hy_ffn_b1, hy_ffn_w2,
                             hy_ffn_b2, hy_ffn_w3, hy_ffn_b3, hy_sin_freq, hy_decay,
                             hy_bias_d, hy_out)
        y_rw = _rwkv7_branch(u_rw, rw_mu, rw_w0, rw_w2, rw_a0, rw_a2, rw_g2, rw_k_k, rw_k_a,
                             rw_r_k, rw_ln_w, rw_ln_b, rw_out)
        merged = jax.nn.sigmoid(g_hy) * y_hy + jax.nn.sigmoid(g_rw) * y_rw
        x = x + merged @ w_out
        x = x + 0.5 * _swiglu(_rmsnorm(x, ffn2_norm), ffn2_w_gu, ffn2_w_down)
    return _rmsnorm(x, final_norm)
```

```cpp
#include <hip/hip_runtime.h>
#include <hip/hip_cooperative_groups.h>
#include <cstdio>
namespace cg = cooperative_groups;
#define LAS __attribute__((address_space(3)))
namespace pg8 {
#define PG8_LAS __attribute__((address_space(3)))
typedef unsigned short bf16_t;
typedef short bf16x8 __attribute__((ext_vector_type(8)));
typedef float f32x4 __attribute__((ext_vector_type(4)));
typedef unsigned u32x4 __attribute__((ext_vector_type(4)));
constexpr int BM = 256, BK = 64, HALF = 128, HTB = HALF * BK * 2, STAGE_BYTES = 8 * HTB, NXCD = 8, WGM = 8;
__host__ __device__ __forceinline__ int lds_byte(int r, int c) { const int st = (r >> 4) * 2 + (c >> 5), rr = r & 15, cc = c & 31, ob = rr * 64 + cc * 2; return st * 1024 + (ob ^ (((ob >> 9) & 1) << 5)); }
__host__ __device__ __forceinline__ void stage_rc(int b, int& R, int& C) { const int st = b / 1024, sb = b % 1024, swz = sb ^ (((sb >> 9) & 1) << 5); R = (st >> 1) * 16 + swz / 64; C = (st & 1) * 32 + (swz % 64) / 2; }
__host__ __device__ __forceinline__ int perm32(int rho) { const int n = rho >> 4, i = rho & 15; return 8 * (i >> 2) + 4 * n + (i & 3); }
struct Unit { int pm, pn; };
struct Gemm { const bf16_t* A; const bf16_t* Bt; int M, N, K, lda, ldb; };
struct StaticOrder {
    int nM, nN, nwg, G, c;
    __host__ __device__ void init(int M, int N, int G_, int c_) { nM = M / BM; nN = N / BM; nwg = nM * nN; G = G_; c = c_; }
    __host__ __device__ bool next(int i, Unit& u) const {
        const long L = (long)i * G + c; if (L >= nwg) return false;
        int wgid = (int)L; { const int q = nwg / NXCD, r = nwg % NXCD, xcd = wgid % NXCD, off = wgid / NXCD; wgid = (xcd < r ? xcd * (q + 1) : r * (q + 1) + (xcd - r) * q) + off; }
        const int nig = WGM * nN, gid = wgid / nig, fm = gid * WGM, gsz = (nM - fm) < WGM ? (nM - fm) : WGM;
        u.pm = fm + ((wgid % nig) % gsz); u.pn = (wgid % nig) / gsz; return true;
    }
    __device__ __forceinline__ void a_ready(const Unit&) const {}
    __device__ __forceinline__ void done(const Unit&) const {}
};
typedef float f32x2c __attribute__((ext_vector_type(2)));
typedef __bf16 bf16x2c __attribute__((ext_vector_type(2)));
__device__ __forceinline__ unsigned cvt_pk_bf16(float lo, float hi) { f32x2c v; v.x = lo; v.y = hi; bf16x2c b = __builtin_convertvector(v, bf16x2c); return __builtin_bit_cast(unsigned, b); }
template <class Epi, class Sched>
__device__ __forceinline__ void gemm_phase(PG8_LAS unsigned char* lds, const Gemm g, const Sched& S, const Epi& E) {
    int tid_ = threadIdx.x; asm volatile("" : "+v"(tid_));
    const int tid = tid_, wid = __builtin_amdgcn_readfirstlane(tid >> 6), lane = tid & 63, wr = wid >> 2, wc = wid & 3, fr = lane & 15, fq = lane >> 4;
    const int K = g.K, nt = K / BK;
    unsigned voffA[2], voffB[2];
#pragma unroll
    for (int i = 0; i < 2; ++i) { int R, C; stage_rc(tid * 16 + i * 8192, R, C); const int Rb = Epi::PERM ? ((R & ~31) + perm32(R & 31)) : R;
        voffA[i] = (unsigned)(R * g.lda + C) * 2u; voffB[i] = (unsigned)(Rb * g.ldb + C) * 2u; }
    const size_t kstep = (size_t)(BK * 2);
    const size_t hstepA = (size_t)HALF * g.lda * 2, hstepB = (size_t)HALF * g.ldb * 2;
    const size_t tstepA = 2 * hstepA, tstepB = 2 * hstepB;
    const unsigned ldsw = (unsigned)wid * 1024u;
    const int aoff = lds_byte(wr * 64 + fr, fq * 8), boff = lds_byte(wc * 32 + fr, fq * 8);
#define PG8_SA(b, h) (((b) * 2 + (h)) * HTB)
#define PG8_SB(b, h) ((4 + (b) * 2 + (h)) * HTB)
#define PG8_STAGE(bufoff, gbase, voff) do { _Pragma("unroll") for (int _i = 0; _i < 2; ++_i) \
        __builtin_amdgcn_global_load_lds((const unsigned*)((const char*)(gbase) + (voff)[_i]), (PG8_LAS unsigned*)(lds + (bufoff) + ldsw + _i * 8192), 16, 0, 0); } while (0)
#define PG8_LDA(dst, b, h) do { _Pragma("unroll") for (int m = 0; m < 4; ++m) _Pragma("unroll") for (int k = 0; k < 2; ++k) dst[m][k] = *(const PG8_LAS bf16x8*)(lds + PG8_SA(b, h) + aoff + m * 2048 + k * 1024); } while (0)
#define PG8_LDB(dst, b, h) do { _Pragma("unroll") for (int n = 0; n < 2; ++n) _Pragma("unroll") for (int k = 0; k < 2; ++k) dst[n][k] = *(const PG8_LAS bf16x8*)(lds + PG8_SB(b, h) + boff + n * 2048 + k * 1024); } while (0)
#define PG8_MMA(ai, bj, At, Bt) do { __builtin_amdgcn_s_setprio(1); _Pragma("unroll") for (int m = 0; m < 4; ++m) _Pragma("unroll") for (int n = 0; n < 2; ++n) _Pragma("unroll") for (int k = 0; k < 2; ++k) \
        acc[ai][bj][m][n] = __builtin_amdgcn_mfma_f32_16x16x32_bf16(Bt[n][k], At[m][k], acc[ai][bj][m][n], 0, 0, 0); __builtin_amdgcn_s_setprio(0); } while (0)
#define PG8_WAIT_V(n) asm volatile("s_waitcnt vmcnt(" #n ")" ::: "memory")
#define PG8_WAIT_L(n) asm volatile("s_waitcnt lgkmcnt(" #n ")" ::: "memory")
#define PG8_BAR __builtin_amdgcn_s_barrier()
#define PG8_SCHED __builtin_amdgcn_sched_barrier(0)
    Unit cur, nxt; int ui = 0;
    if (!S.next(0, cur)) return;
    f32x4 acc[2][2][4][2];
#pragma unroll
    for (int a = 0; a < 2; ++a)
#pragma unroll
        for (int b = 0; b < 2; ++b)
#pragma unroll
            for (int m = 0; m < 4; ++m)
#pragma unroll
                for (int n = 0; n < 2; ++n) acc[a][b][m][n] = (f32x4){0.f, 0.f, 0.f, 0.f};
    bf16x8 At[4][2], B0[2][2], B1[2][2];
    const char* cA = (const char*)g.A + (size_t)cur.pm * tstepA; const char* cB = (const char*)g.Bt + (size_t)cur.pn * tstepB;
    S.a_ready(cur);
    PG8_STAGE(PG8_SB(0, 0), cB, voffB); PG8_STAGE(PG8_SA(0, 0), cA, voffA); PG8_STAGE(PG8_SB(0, 1), cB + hstepB, voffB); PG8_STAGE(PG8_SA(0, 1), cA + hstepA, voffA);
    if (wr == 1) PG8_BAR;
    PG8_WAIT_V(4); PG8_BAR;
    PG8_STAGE(PG8_SB(1, 0), cB + kstep, voffB); PG8_STAGE(PG8_SA(1, 0), cA + kstep, voffA); PG8_STAGE(PG8_SB(1, 1), cB + hstepB + kstep, voffB);
    PG8_WAIT_V(6); PG8_BAR;
    for (;;) {
        const bool has_next = S.next(ui + 1, nxt);
        const char* nA = has_next ? (const char*)g.A + (size_t)nxt.pm * tstepA : cA; const char* nB = has_next ? (const char*)g.Bt + (size_t)nxt.pn * tstepB : cB;
        for (int t = 0; t < nt; t += 2) {
            const bool last = (t == nt - 2);
            const char* a1 = cA + (size_t)(t + 1) * kstep;
            const char* a2 = last ? nA : cA + (size_t)(t + 2) * kstep; const char* b2 = last ? nB : cB + (size_t)(t + 2) * kstep;
            const char* a3 = a2 + kstep; const char* b3 = b2 + kstep;
            if (last && has_next) S.a_ready(nxt);
            PG8_LDB(B0, 0, 0); PG8_SCHED; PG8_LDA(At, 0, 0); PG8_STAGE(PG8_SA(1, 1), a1 + hstepA, voffA);
            PG8_WAIT_L(8); PG8_BAR; PG8_WAIT_L(0); PG8_MMA(0, 0, At, B0); PG8_BAR; PG8_SCHED;
            PG8_LDB(B1, 0, 1); PG8_STAGE(PG8_SB(0, 0), b2, voffB);
            PG8_BAR; PG8_WAIT_L(0); PG8_MMA(0, 1, At, B1); PG8_BAR;
            PG8_LDA(At, 0, 1); PG8_STAGE(PG8_SA(0, 0), a2, voffA);
            PG8_BAR; PG8_WAIT_L(0); PG8_MMA(1, 0, At, B0); PG8_BAR; PG8_SCHED;
            PG8_STAGE(PG8_SB(0, 1), b2 + hstepB, voffB);
            PG8_WAIT_V(6); PG8_BAR; PG8_MMA(1, 1, At, B1); PG8_BAR;
            PG8_LDB(B0, 1, 0); PG8_SCHED; PG8_LDA(At, 1, 0); PG8_STAGE(PG8_SA(0, 1), a2 + hstepA, voffA);
            PG8_WAIT_L(8); PG8_BAR; PG8_WAIT_L(0); PG8_MMA(0, 0, At, B0); PG8_BAR; PG8_SCHED;
            PG8_LDB(B1, 1, 1); PG8_STAGE(PG8_SB(1, 0), b3, voffB);
            PG8_BAR; PG8_WAIT_L(0); PG8_MMA(0, 1, At, B1); PG8_BAR;
            PG8_LDA(At, 1, 1); PG8_STAGE(PG8_SA(1, 0), a3, voffA);
            PG8_BAR; PG8_WAIT_L(0); PG8_MMA(1, 0, At, B0); PG8_BAR; PG8_SCHED;
            PG8_STAGE(PG8_SB(1, 1), b3 + hstepB, voffB);
            PG8_WAIT_V(6); PG8_BAR; PG8_MMA(1, 1, At, B1); PG8_BAR;
        }
        if constexpr (!Epi::AFTER_DRAIN) { E(acc, cur, wr, wc, fr, fq); S.done(cur); }
        if (!has_next) break;
#pragma unroll
        for (int a = 0; a < 2; ++a)
#pragma unroll
            for (int b = 0; b < 2; ++b)
#pragma unroll
                for (int m = 0; m < 4; ++m)
#pragma unroll
                    for (int n = 0; n < 2; ++n) acc[a][b][m][n] = (f32x4){0.f, 0.f, 0.f, 0.f};
        cur = nxt; cA = nA; cB = nB; ++ui;
    }
    PG8_WAIT_V(0);
    if (wr == 0) PG8_BAR;
    PG8_BAR;
    if constexpr (Epi::AFTER_DRAIN) { E.fused(acc, cur, wr, wc, fr, fq, lds, wid, lane); S.done(cur); }
#undef PG8_SA
#undef PG8_SB
#undef PG8_STAGE
#undef PG8_LDA
#undef PG8_LDB
#undef PG8_MMA
#undef PG8_WAIT_V
#undef PG8_WAIT_L
#undef PG8_BAR
#undef PG8_SCHED
}
}
using pg8::bf16_t; using pg8::bf16x8; using pg8::f32x4; using pg8::u32x4; using pg8::Unit; using pg8::BM; using pg8::HALF;
typedef unsigned u32x2 __attribute__((ext_vector_type(2)));
typedef float f32x2 __attribute__((ext_vector_type(2)));

constexpr int T = 32768, SEQ = 4096, DM = 1024, DFF = 2816;
constexpr size_t MiB = 1ull << 20;
constexpr size_t OFF_WBF = 0, OFF_A = 52 * MiB, OFF_B = 116 * MiB;
constexpr size_t OFF_KRAW = 292 * MiB, OFF_KF = 324 * MiB, OFF_MLP = 510 * MiB;
constexpr size_t OFF_UTHY = 116 * MiB, OFF_URW = 388 * MiB, OFF_ZT = 212 * MiB;
constexpr size_t OFF_R = 52 * MiB, OFF_K = 84 * MiB, OFF_KK = 116 * MiB, OFF_AF = 148 * MiB, OFF_AB = 180 * MiB, OFF_LWF = 244 * MiB, OFF_LWB = 276 * MiB, OFF_G = 308 * MiB, OFF_V = 340 * MiB, OFF_BONUS = 372 * MiB;
constexpr size_t OFF_MH = 372 * MiB, OFF_MR = 436 * MiB;
constexpr size_t OFF_YF = 388 * MiB, OFF_YB = 420 * MiB, OFF_ACAT = 116 * MiB, OFF_GATES = 244 * MiB, OFF_MERGED = 372 * MiB;
constexpr size_t W_GU1 = 0, W_D1 = W_GU1 + 5632ull * 1024, W_INHY = W_D1 + 1024ull * 2816, W_INRW = W_INHY + 1536ull * 1024, W_GT = W_INRW + 2048ull * 1024,
                 W_HY = W_GT + 2048ull * 1024, W_RW = W_HY + 1024ull * 512, W_O = W_RW + 1024ull * 512, W_GU2 = W_O + 1024ull * 1024, W_D2 = W_GU2 + 5632ull * 1024,
                 W_W2T = W_D2 + 1024ull * 2816, W_A2T = W_W2T + 2ull * 512 * 64, W_G2T = W_A2T + 2ull * 512 * 64, W_END = W_G2T + 512ull * 160;
static_assert(W_END * 2 <= 52 * MiB, "wbf");
constexpr int LDS_BYTES = 147456;
constexpr size_t OFF_BAR = 511 * MiB;
constexpr size_t OFF_X3 = 292 * MiB;

struct Args { const float* in[35]; float* out; unsigned char* ws; };

__device__ __forceinline__ int TIDX() { int t = threadIdx.x; asm volatile("" : "+v"(t)); return t; }
__device__ __forceinline__ float bf2f(unsigned short b) { return __uint_as_float((unsigned)b << 16); }
__device__ __forceinline__ float bflo(unsigned w) { return __uint_as_float(w << 16); }
__device__ __forceinline__ float bfhi(unsigned w) { return __uint_as_float(w & 0xffff0000u); }
__device__ __forceinline__ unsigned pk2(float lo, float hi) { return pg8::cvt_pk_bf16(lo, hi); }
__device__ __forceinline__ bf16_t f2bf(float f) { return (bf16_t)(pk2(f, 0.f) & 0xffffu); }
__device__ __forceinline__ float sigm(float x) { return __builtin_amdgcn_rcpf(1.f + __expf(-x)); }
__device__ __forceinline__ float wave_sum(float s) { for (int o = 32; o > 0; o >>= 1) s += __shfl_xor(s, o); return s; }
template <int CTRL> __device__ __forceinline__ float dpp_f(float x) { return __int_as_float(__builtin_amdgcn_update_dpp(0, __float_as_int(x), CTRL, 0xf, 0xf, false)); }
__device__ __forceinline__ float row16_allsum(float x) { x += dpp_f<0x128>(x); x += dpp_f<0x124>(x); x += dpp_f<0x122>(x); x += dpp_f<0x121>(x); return x; }
__device__ __forceinline__ float row16_allsum_r(float x) { x += dpp_f<0x121>(x); x += dpp_f<0x122>(x); x += dpp_f<0x124>(x); x += dpp_f<0x128>(x); return x; }

struct EpiGU {
    static constexpr bool PERM = true, AFTER_DRAIN = false;
    bf16_t* O;
    __device__ __forceinline__ void operator()(const f32x4 (&acc)[2][2][4][2], const Unit& u, int wr, int wc, int fr, int fq) const {
        const int row0 = u.pm * BM + wr * 64 + fr, col0 = u.pn * 128 + wc * 32 + 8 * fq;
#pragma unroll
        for (int ai = 0; ai < 2; ++ai)
#pragma unroll
            for (int m = 0; m < 4; ++m) {
                float h[8];
#pragma unroll
                for (int n = 0; n < 2; ++n)
#pragma unroll
                    for (int j = 0; j < 4; ++j) { const float g = acc[ai][0][m][n][j], up = acc[ai][1][m][n][j]; h[n * 4 + j] = g * sigm(g) * up; }
                u32x4 w; w.x = pk2(h[0], h[1]); w.y = pk2(h[2], h[3]); w.z = pk2(h[4], h[5]); w.w = pk2(h[6], h[7]);
                *(u32x4*)(O + (size_t)(row0 + ai * HALF + m * 16) * DFF + col0) = w;
            }
    }
};
template <int BB  , int OB  > struct EpiResidT {
    static constexpr bool PERM = true, AFTER_DRAIN = false;
    const void* base; void* out; float scale;
    __device__ __forceinline__ void operator()(const f32x4 (&acc)[2][2][4][2], const Unit& u, int wr, int wc, int fr, int fq) const {
        const int row0 = u.pm * BM + wr * 64 + fr, col0 = u.pn * BM + wc * 32 + 8 * fq;
#pragma unroll
        for (int ai = 0; ai < 2; ++ai)
#pragma unroll
            for (int m = 0; m < 4; ++m) { const size_t off = (size_t)(row0 + ai * HALF + m * 16) * DM + col0;
#pragma unroll
                for (int bj = 0; bj < 2; ++bj) { const size_t o2 = off + bj * HALF; f32x4 b0, b1;
                    if (BB) { const u32x4 t = *(const u32x4*)((const bf16_t*)base + o2); b0[0] = bflo(t.x); b0[1] = bfhi(t.x); b0[2] = bflo(t.y); b0[3] = bfhi(t.y); b1[0] = bflo(t.z); b1[1] = bfhi(t.z); b1[2] = bflo(t.w); b1[3] = bfhi(t.w); }
                    else { b0 = *(const f32x4*)((const float*)base + o2); b1 = *(const f32x4*)((const float*)base + o2 + 4); }
                    const f32x4 x0 = b0 + acc[ai][bj][m][0] * scale, x1 = b1 + acc[ai][bj][m][1] * scale;
                    if (OB) { u32x4 w; w.x = pk2(x0[0], x0[1]); w.y = pk2(x0[2], x0[3]); w.z = pk2(x1[0], x1[1]); w.w = pk2(x1[2], x1[3]); *(u32x4*)((bf16_t*)out + o2) = w; }
                    else { *(f32x4*)((float*)out + o2) = x0; *(f32x4*)((float*)out + o2 + 4) = x1; } } }
    }
};
template <int ACT> struct EpiBf16 {
    static constexpr bool PERM = true, AFTER_DRAIN = false;
    bf16_t* O; int ldc; int ncols;
    __device__ __forceinline__ void operator()(const f32x4 (&acc)[2][2][4][2], const Unit& u, int wr, int wc, int fr, int fq) const {
        const int row0 = u.pm * BM + wr * 64 + fr, col0 = u.pn * BM + wc * 32 + 8 * fq;
#pragma unroll
        for (int ai = 0; ai < 2; ++ai)
#pragma unroll
            for (int m = 0; m < 4; ++m)
#pragma unroll
                for (int bj = 0; bj < 2; ++bj) { const int col = col0 + bj * HALF; f32x4 v0 = acc[ai][bj][m][0], v1 = acc[ai][bj][m][1];
                    if (ACT == 1) {
#pragma unroll
                        for (int j = 0; j < 4; ++j) { v0[j] = sigm(v0[j]); v1[j] = sigm(v1[j]); } }
                    u32x4 w; w.x = pk2(v0[0], v0[1]); w.y = pk2(v0[2], v0[3]); w.z = pk2(v1[0], v1[1]); w.w = pk2(v1[2], v1[3]);
                    if (col < ncols) *(u32x4*)(O + (size_t)(row0 + ai * HALF + m * 16) * ldc + col) = w; }
    }
};
template <int SECOND> struct EpiMerge {
    static constexpr bool PERM = true, AFTER_DRAIN = false;
    bf16_t* Mg; const bf16_t* gates; int goff;
    __device__ __forceinline__ void operator()(const f32x4 (&acc)[2][2][4][2], const Unit& u, int wr, int wc, int fr, int fq) const {
        const int row0 = u.pm * BM + wr * 64 + fr, col0 = u.pn * BM + wc * 32 + 8 * fq;
#pragma unroll
        for (int ai = 0; ai < 2; ++ai)
#pragma unroll
            for (int m = 0; m < 4; ++m)
#pragma unroll
                for (int bj = 0; bj < 2; ++bj) { const int col = col0 + bj * HALF; const size_t row = (size_t)(row0 + ai * HALF + m * 16);
                    const u32x4 gt = *(const u32x4*)(gates + row * 2048 + goff + col);
                    float o[8]; const f32x4 v0 = acc[ai][bj][m][0], v1 = acc[ai][bj][m][1];
#ifdef EXP5
                    o[0] = bflo(gt.x); o[1] = bfhi(gt.x); o[2] = bflo(gt.y); o[3] = bfhi(gt.y); o[4] = bflo(gt.z); o[5] = bfhi(gt.z); o[6] = bflo(gt.w); o[7] = bfhi(gt.w);
#else
                    o[0] = bflo(gt.x) * v0[0]; o[1] = bfhi(gt.x) * v0[1]; o[2] = bflo(gt.y) * v0[2]; o[3] = bfhi(gt.y) * v0[3];
                    o[4] = bflo(gt.z) * v1[0]; o[5] = bfhi(gt.z) * v1[1]; o[6] = bflo(gt.w) * v1[2]; o[7] = bfhi(gt.w) * v1[3];
#endif
                    if (SECOND) { const u32x4 pm = *(const u32x4*)(Mg + row * DM + col);
                        o[0] += bflo(pm.x); o[1] += bfhi(pm.x); o[2] += bflo(pm.y); o[3] += bfhi(pm.y); o[4] += bflo(pm.z); o[5] += bfhi(pm.z); o[6] += bflo(pm.w); o[7] += bfhi(pm.w); }
                    u32x4 w; w.x = pk2(o[0], o[1]); w.y = pk2(o[2], o[3]); w.z = pk2(o[4], o[5]); w.w = pk2(o[6], o[7]);
                    *(u32x4*)(Mg + row * DM + col) = w; }
    }
};
template <class Epi> __device__ __forceinline__ void run_gemm(LAS unsigned char* lds, const bf16_t* A, int lda, const bf16_t* Bt, int ldb, int M, int N, int K, const Epi& E) {
    pg8::Gemm g; g.A = A; g.Bt = Bt; g.M = M; g.N = N; g.K = K; g.lda = lda; g.ldb = ldb;
    pg8::StaticOrder S; S.init(M, N, gridDim.x, blockIdx.x);
#ifndef NO_GEMM
    pg8::gemm_phase(lds, g, S, E);
#endif
}

__device__ __forceinline__ void norm_rows_bf16(const float* __restrict__ X, const float* __restrict__ g, bf16_t* __restrict__ H) {
    const int lane = TIDX() & 63, wid = TIDX() >> 6;
#pragma unroll 4
    for (int row = blockIdx.x * 8 + wid; row < T; row += gridDim.x * 8) {
        const float4* p = (const float4*)(X + (size_t)row * DM);
        float4 v[4]; float s = 0.f;
#pragma unroll
        for (int j = 0; j < 4; ++j) { v[j] = p[lane + 64 * j]; s += v[j].x * v[j].x + v[j].y * v[j].y + v[j].z * v[j].z + v[j].w * v[j].w; }
        s = wave_sum(s);
        const float r = rsqrtf(s * (1.f / DM) + 1e-6f);
#pragma unroll
        for (int j = 0; j < 4; ++j) { const float4 gg = ((const float4*)g)[lane + 64 * j]; u32x2 o; o.x = pk2(v[j].x * r * gg.x, v[j].y * r * gg.y); o.y = pk2(v[j].z * r * gg.z, v[j].w * r * gg.w);
            *(u32x2*)(H + (size_t)row * DM + (lane + 64 * j) * 4) = o; }
    }
}
__device__ __forceinline__ void norm_rows_bf16in(const bf16_t* __restrict__ X, const float* __restrict__ g, bf16_t* __restrict__ H) {
    const int lane = TIDX() & 63, wid = TIDX() >> 6;
#pragma unroll 4
    for (int row = blockIdx.x * 8 + wid; row < T; row += gridDim.x * 8) {
        const u32x4* p = (const u32x4*)(X + (size_t)row * DM);
        float v[16]; float s = 0.f;
#pragma unroll
        for (int j = 0; j < 2; ++j) { const u32x4 t = p[lane + 64 * j];
            v[8 * j + 0] = bflo(t.x); v[8 * j + 1] = bfhi(t.x); v[8 * j + 2] = bflo(t.y); v[8 * j + 3] = bfhi(t.y); v[8 * j + 4] = bflo(t.z); v[8 * j + 5] = bfhi(t.z); v[8 * j + 6] = bflo(t.w); v[8 * j + 7] = bfhi(t.w); }
#pragma unroll
        for (int i = 0; i < 16; ++i) s += v[i] * v[i];
        s = wave_sum(s);
        const float r = rsqrtf(s * (1.f / DM) + 1e-6f);
#pragma unroll
        for (int j = 0; j < 2; ++j) { const int c0 = (lane + 64 * j) * 8; const float4 ga = *(const float4*)(g + c0), gb = *(const float4*)(g + c0 + 4);
            u32x4 o; o.x = pk2(v[8 * j] * r * ga.x, v[8 * j + 1] * r * ga.y); o.y = pk2(v[8 * j + 2] * r * ga.z, v[8 * j + 3] * r * ga.w);
            o.z = pk2(v[8 * j + 4] * r * gb.x, v[8 * j + 5] * r * gb.y); o.w = pk2(v[8 * j + 6] * r * gb.z, v[8 * j + 7] * r * gb.w);
            *(u32x4*)(H + (size_t)row * DM + c0) = o; }
    }
}
__device__ __forceinline__ void norm_rows_bf16_to_f32(const bf16_t* __restrict__ X, const float* __restrict__ g, float* __restrict__ O) {
    const int lane = TIDX() & 63, wid = TIDX() >> 6;
#pragma unroll 4
    for (int row = blockIdx.x * 8 + wid; row < T; row += gridDim.x * 8) {
        const u32x4* p = (const u32x4*)(X + (size_t)row * DM);
        float v[16]; float s = 0.f;
#pragma unroll
        for (int j = 0; j < 2; ++j) { const u32x4 t = p[lane + 64 * j];
            v[8 * j + 0] = bflo(t.x); v[8 * j + 1] = bfhi(t.x); v[8 * j + 2] = bflo(t.y); v[8 * j + 3] = bfhi(t.y); v[8 * j + 4] = bflo(t.z); v[8 * j + 5] = bfhi(t.z); v[8 * j + 6] = bflo(t.w); v[8 * j + 7] = bfhi(t.w); }
#pragma unroll
        for (int i = 0; i < 16; ++i) s += v[i] * v[i];
        s = wave_sum(s);
        const float r = rsqrtf(s * (1.f / DM) + 1e-6f);
#pragma unroll
        for (int j = 0; j < 2; ++j) { const int c0 = (lane + 64 * j) * 8; const float4 ga = *(const float4*)(g + c0), gb = *(const float4*)(g + c0 + 4);
            float4 o0, o1; o0.x = v[8 * j] * r * ga.x; o0.y = v[8 * j + 1] * r * ga.y; o0.z = v[8 * j + 2] * r * ga.z; o0.w = v[8 * j + 3] * r * ga.w;
            o1.x = v[8 * j + 4] * r * gb.x; o1.y = v[8 * j + 5] * r * gb.y; o1.z = v[8 * j + 6] * r * gb.z; o1.w = v[8 * j + 7] * r * gb.w;
            *(float4*)(O + (size_t)row * DM + c0) = o0; *(float4*)(O + (size_t)row * DM + c0 + 4) = o1; }
    }
}
__device__ __forceinline__ void norm_rows_f32_out(const float* X, const float* g, float* O) {
    const int lane = TIDX() & 63, wid = TIDX() >> 6;
    for (int row = blockIdx.x * 8 + wid; row < T; row += gridDim.x * 8) {
        const float4* p = (const float4*)(X + (size_t)row * DM); float4* q = (float4*)(O + (size_t)row * DM);
        float4 v[4]; float s = 0.f;
#pragma unroll
        for (int j = 0; j < 4; ++j) { v[j] = p[lane + 64 * j]; s += v[j].x * v[j].x + v[j].y * v[j].y + v[j].z * v[j].z + v[j].w * v[j].w; }
        s = wave_sum(s);
        const float r = rsqrtf(s * (1.f / DM) + 1e-6f);
#pragma unroll
        for (int j = 0; j < 4; ++j) { const float4 gg = ((const float4*)g)[lane + 64 * j]; float4 o; o.x = v[j].x * r * gg.x; o.y = v[j].y * r * gg.y; o.z = v[j].z * r * gg.z; o.w = v[j].w * r * gg.w; q[lane + 64 * j] = o; }
    }
}
__device__ __forceinline__ void norm_rows_f32_inplace(float* X, const float* g) {
    const int lane = TIDX() & 63, wid = TIDX() >> 6;
    for (int row = blockIdx.x * 8 + wid; row < T; row += gridDim.x * 8) {
        float4* p = (float4*)(X + (size_t)row * DM);
        float4 v[4]; float s = 0.f;
#pragma unroll
        for (int j = 0; j < 4; ++j) { v[j] = p[lane + 64 * j]; s += v[j].x * v[j].x + v[j].y * v[j].y + v[j].z * v[j].z + v[j].w * v[j].w; }
        s = wave_sum(s);
        const float r = rsqrtf(s * (1.f / DM) + 1e-6f);
#pragma unroll
        for (int j = 0; j < 4; ++j) { const float4 gg = ((const float4*)g)[lane + 64 * j]; float4 o; o.x = v[j].x * r * gg.x; o.y = v[j].y * r * gg.y; o.z = v[j].z * r * gg.z; o.w = v[j].w * r * gg.w; p[lane + 64 * j] = o; }
    }
}
template <class FN> __device__ __forceinline__ void cvt_wT(const float* __restrict__ src, int ldsrc, bf16_t* __restrict__ dst, int N, int K, FN srccol) {
    const size_t total = (size_t)N * (K >> 3), gstride = (size_t)gridDim.x * 512;
    for (size_t it = (size_t)blockIdx.x * 512 + TIDX(); it < total; it += gstride) {
        const int n = (int)(it % N), k8 = (int)(it / N); const int sc = srccol(n);
        float f[8];
#pragma unroll
        for (int i = 0; i < 8; ++i) f[i] = sc >= 0 ? src[(size_t)(k8 * 8 + i) * ldsrc + sc] : 0.f;
        u32x4 o; o.x = pk2(f[0], f[1]); o.y = pk2(f[2], f[3]); o.z = pk2(f[4], f[5]); o.w = pk2(f[6], f[7]);
        *(u32x4*)(dst + (size_t)n * K + k8 * 8) = o;
    }
}
template <class FN> __device__ __forceinline__ void cvt_wT_tiled(LAS unsigned char* lds, const float* __restrict__ src, int ldsrc, bf16_t* __restrict__ dst, int N, int K, FN srccol) {
    LAS float* tile = (LAS float*)lds;
    const int tid = TIDX(), nK = K >> 6, ntiles = (N >> 6) * nK;
    for (int it = blockIdx.x; it < ntiles; it += gridDim.x) {
        const int n0 = (it / nK) << 6, k0 = (it % nK) << 6;
        __syncthreads();
        { const int n = tid & 63, kq = tid >> 6; const int sc = srccol(n0 + n);
#pragma unroll
          for (int i = 0; i < 8; ++i) { const int k = kq + 8 * i; tile[k * 65 + n] = sc >= 0 ? src[(size_t)(k0 + k) * ldsrc + sc] : 0.f; } }
        __syncthreads();
        { const int n = tid >> 3, k8 = tid & 7; float f[8];
#pragma unroll
          for (int i = 0; i < 8; ++i) f[i] = tile[(k8 * 8 + i) * 65 + n];
          u32x4 o; o.x = pk2(f[0], f[1]); o.y = pk2(f[2], f[3]); o.z = pk2(f[4], f[5]); o.w = pk2(f[6], f[7]);
          *(u32x4*)(dst + (size_t)(n0 + n) * K + k0 + k8 * 8) = o; }
    }
}
__device__ __forceinline__ int gu_col(int n) { const int pn = n >> 8, w = n & 255; return w < 128 ? pn * 128 + w : DFF + pn * 128 + (w - 128); }

__device__ __forceinline__ void merge_phase(const bf16_t* gates, const bf16_t* MH, const bf16_t* MR, bf16_t* merged) {
    const size_t n8 = (size_t)T * DM / 8;
    for (size_t i = (size_t)blockIdx.x * 512 + TIDX(); i < n8; i += (size_t)gridDim.x * 512) {
        const size_t row = i >> 7, c8 = (i & 127) * 8;
#ifdef EXP9
        const u32x4 gh = {0x3f003f00u, 0x3f003f00u, 0x3f003f00u, 0x3f003f00u}, gr = gh;
#else
        const u32x4 gh = *(const u32x4*)(gates + row * 2048 + c8), gr = *(const u32x4*)(gates + row * 2048 + 1024 + c8);
#endif
        const u32x4 mh = *(const u32x4*)(MH + i * 8), mr = *(const u32x4*)(MR + i * 8);
        u32x4 w;
        w.x = pk2(bflo(gh.x) * bflo(mh.x) + bflo(gr.x) * bflo(mr.x), bfhi(gh.x) * bfhi(mh.x) + bfhi(gr.x) * bfhi(mr.x));
        w.y = pk2(bflo(gh.y) * bflo(mh.y) + bflo(gr.y) * bflo(mr.y), bfhi(gh.y) * bfhi(mh.y) + bfhi(gr.y) * bfhi(mr.y));
        w.z = pk2(bflo(gh.z) * bflo(mh.z) + bflo(gr.z) * bflo(mr.z), bfhi(gh.z) * bfhi(mh.z) + bfhi(gr.z) * bfhi(mr.z));
        w.w = pk2(bflo(gh.w) * bflo(mh.w) + bflo(gr.w) * bflo(mr.w), bfhi(gh.w) * bfhi(mh.w) + bfhi(gr.w) * bfhi(mr.w));
        *(u32x4*)(merged + i * 8) = w;
    }
}
__device__ __forceinline__ void hy_mlp_phase(LAS unsigned char* lds, const float* w1, const float* b1, const float* w2, const float* b2, const float* fr, float* mlp) {
    const int lane = TIDX() & 63, wid = TIDX() >> 6;
    LAS float* sh = (LAS float*)lds;
    for (int pb = blockIdx.x; pb < 512; pb += gridDim.x) {
        const int p = pb * 8 + wid, j = lane;
        const float tt = (float)p / 4095.f, ang = (float)(2.0 * 3.14159265358979323846 / 4096.0) * (float)p;
        float a1 = b1[j] + tt * w1[j];
        for (int i = 0; i < 16; ++i) { const float band = 1e-4f + (float)i * ((15.f - 1e-4f) / 15.f); float sn, cs; sincosf(band * ang, &sn, &cs); a1 += cs * w1[(1 + i) * 64 + j] - sn * w1[(17 + i) * 64 + j]; }
        const float f = fr[j];
        sh[wid * 64 + j] = sinf(f * a1);
        __syncthreads();
        float a2 = b2[j];
        for (int m = 0; m < 64; ++m) a2 += sh[wid * 64 + m] * w2[m * 64 + j];
        mlp[p * 64 + j] = sinf(f * a2);
        __syncthreads();
    }
}
__device__ __forceinline__ void hy_kraw_phase(LAS unsigned char* lds, const float* w3, const float* b3, const float* decay, const float* mlp, float* kraw) {
    const int tid = TIDX(), lane = tid & 63, wid = tid >> 6;
    LAS float* w3s = (LAS float*)lds;
    for (int item = blockIdx.x; item < 256; item += gridDim.x) {
        const int ob = item >> 3, pg = item & 7;
        __syncthreads();
        for (int e = tid; e < 4096; e += 512) w3s[e] = w3[(size_t)(e >> 6) * 2048 + ob * 64 + (e & 63)];
        __syncthreads();
        const int p = (pg * 8 + wid) * 64 + lane;
        float h[64];
#pragma unroll
        for (int q = 0; q < 16; ++q) { const float4 t4 = *(const float4*)(mlp + (size_t)p * 64 + q * 4); h[q * 4] = t4.x; h[q * 4 + 1] = t4.y; h[q * 4 + 2] = t4.z; h[q * 4 + 3] = t4.w; }
        const float tt = (float)p / 4095.f;
        for (int o4 = 0; o4 < 16; ++o4) {
            const int og0 = ob * 64 + o4 * 4;
            float4 acc = *(const float4*)(b3 + og0);
#pragma unroll
            for (int m = 0; m < 64; ++m) { const f32x4 w = *(const LAS f32x4*)(w3s + m * 64 + o4 * 4); acc.x += h[m] * w.x; acc.y += h[m] * w.y; acc.z += h[m] * w.z; acc.w += h[m] * w.w; }
            const float av[4] = {acc.x, acc.y, acc.z, acc.w};
#pragma unroll
            for (int q = 0; q < 4; ++q) { const int og = og0 + q, dir = og >> 10; const float dec = fabsf(decay[og]);
                float val = av[q] * __expf(-tt * dec);
                int j = p; if (dir) { j = (p == 0) ? 4096 : 8192 - p; if (p == 0) val = 0.f; }
                kraw[(size_t)(og & 1023) * 8192 + j] = val; }
        }
    }
}
#define FPAD(i) ((i) + ((i) >> 3))
constexpr int FFT_X_BYTES = (8192 + 1024) * 8, FFT_TW_OFF = FFT_X_BYTES, FFT_RED_OFF = FFT_TW_OFF + 4096 * 8;
__device__ __forceinline__ f32x2 mk2(float a, float b) { f32x2 r; r.x = a; r.y = b; return r; }
__device__ __forceinline__ f32x2 cmul(f32x2 a, f32x2 b) { return mk2(a.x * b.x - a.y * b.y, a.x * b.y + a.y * b.x); }
__device__ __forceinline__ f32x2 cmulc(f32x2 a, f32x2 b) { return mk2(a.x * b.x + a.y * b.y, a.y * b.x - a.x * b.y); }
__device__ __forceinline__ f32x2 cexp16(int q) {
    constexpr float CT[9] = {1.f, 0.98078528040f, 0.92387953251f, 0.83146961230f, 0.70710678119f, 0.55557023302f, 0.38268343236f, 0.19509032202f, 0.f};
    const float c = q <= 8 ? CT[q] : -CT[16 - q]; const float s = q <= 8 ? CT[8 - q] : CT[q - 8]; return mk2(c, -s);
}
template <int S, int HSL, bool INV> __device__ __forceinline__ void fft_pass(LAS f32x2* X, const LAS f32x2* tw) {
    constexpr int R = 1 << S, hs = 1 << HSL;
    for (int g = TIDX(); g < (8192 >> S); g += 512) {
        const int lo = g & (hs - 1), i0 = ((g >> HSL) << (HSL + S)) + lo;
        f32x2 v[R];
#pragma unroll
        for (int m = 0; m < R; ++m) v[m] = X[FPAD(i0 + m * hs)];
        f32x2 B[S];
        B[0] = (HSL == 0) ? mk2(1.f, 0.f) : tw[lo << (12 - HSL - (S - 1))];
#pragma unroll
        for (int s = 1; s < S; ++s) B[s] = cmul(B[s - 1], B[s - 1]);
#pragma unroll
        for (int ss = 0; ss < S; ++ss) {
            const int s = INV ? (S - 1 - ss) : ss; const int ms = 1 << (S - 1 - s);
#pragma unroll
            for (int m = 0; m < R; ++m) if (!(m & ms)) {
                const int q = (m & (ms - 1)) * (16 / ms);
                const f32x2 w = (HSL == 0) ? cexp16(q) : (q == 0 ? B[s] : cmul(B[s], cexp16(q)));
                if (!INV) { const f32x2 a = v[m], b = v[m + ms]; v[m] = a + b; v[m + ms] = cmul(a - b, w); }
                else { const f32x2 a = v[m], b = cmulc(v[m + ms], w); v[m] = a + b; v[m + ms] = a - b; }
            }
        }
#pragma unroll
        for (int m = 0; m < R; ++m) X[FPAD(i0 + m * hs)] = v[m];
    }
    __syncthreads();
}
__device__ __forceinline__ void fft_mid(LAS f32x2* X, const f32x2* kf) {
    for (int g = TIDX(); g < 1024; g += 512) {
        const int i0 = g * 8;
        f32x2 v[8];
#pragma unroll
        for (int m = 0; m < 8; ++m) v[m] = X[FPAD(i0 + m)];
#pragma unroll
        for (int s = 0; s < 3; ++s) { const int ms = 4 >> s;
#pragma unroll
            for (int m = 0; m < 8; ++m) if (!(m & ms)) { const f32x2 w = cexp16((m & (ms - 1)) * (16 / ms)); const f32x2 a = v[m], b = v[m + ms]; v[m] = a + b; v[m + ms] = cmul(a - b, w); } }
#pragma unroll
        for (int m = 0; m < 8; ++m) v[m] = cmul(v[m], kf[i0 + m]);
#pragma unroll
        for (int s = 2; s >= 0; --s) { const int ms = 4 >> s;
#pragma unroll
            for (int m = 0; m < 8; ++m) if (!(m & ms)) { const f32x2 w = cexp16((m & (ms - 1)) * (16 / ms)); const f32x2 a = v[m], b = cmulc(v[m + ms], w); v[m] = a + b; v[m + ms] = a - b; } }
#pragma unroll
        for (int m = 0; m < 8; ++m) X[FPAD(i0 + m)] = v[m];
    }
    __syncthreads();
}
__device__ __forceinline__ void fft_fwd3(LAS f32x2* X, const LAS f32x2* tw) { fft_pass<4, 9, false>(X, tw); fft_pass<3, 6, false>(X, tw); fft_pass<3, 3, false>(X, tw); }
__device__ __forceinline__ void fft_fwd(LAS f32x2* X, const LAS f32x2* tw) { fft_fwd3(X, tw); fft_pass<3, 0, false>(X, tw); }
__device__ __forceinline__ void fft_inv3(LAS f32x2* X, const LAS f32x2* tw) { fft_pass<3, 3, true>(X, tw); fft_pass<3, 6, true>(X, tw); fft_pass<4, 9, true>(X, tw); }
__device__ __forceinline__ void build_tw(LAS f32x2* tw) { for (int e = TIDX(); e < 4096; e += 512) { float s, c; sincospif(-(float)e / 4096.f, &s, &c); tw[e] = mk2(c, s); } __syncthreads(); }

__device__ __forceinline__ void hy_filter_fft_phase(LAS unsigned char* lds, const float* kraw, f32x2* Kf) {
    const int tid = TIDX(), lane = tid & 63, wid = tid >> 6;
    LAS f32x2* X = (LAS f32x2*)lds; LAS f32x2* tw = (LAS f32x2*)(lds + FFT_TW_OFF); LAS float* red = (LAS float*)(lds + FFT_RED_OFF);
    build_tw(tw);
    for (int f = blockIdx.x; f < 1024; f += gridDim.x) {
        float ss = 0.f;
        for (int i = tid; i < 8192; i += 512) { const float v = kraw[(size_t)f * 8192 + i]; ss += v * v; X[FPAD(i)] = mk2(v, 0.f); }
        ss = wave_sum(ss); if (lane == 0) red[wid] = ss;
        __syncthreads();
        float tot = 0.f;
#pragma unroll
        for (int w = 0; w < 8; ++w) tot += red[w];
        fft_fwd(X, tw);
        const float sc = rsqrtf(tot + 1e-6f) * (1.f / 8192.f);
        for (int i = tid; i < 8192; i += 512) { const f32x2 v = X[FPAD(i)]; Kf[(size_t)f * 8192 + i] = v * sc; }
        __syncthreads();
    }
}
__device__ __forceinline__ float conv3at(const bf16_t* row, int t, float w0, float w1, float w2, float bb) {
    const float um = t > 0 ? bf2f(row[t - 1]) : 0.f, u0 = bf2f(row[t]), up = t < SEQ - 1 ? bf2f(row[t + 1]) : 0.f;
    return w0 * um + w1 * u0 + w2 * up + bb;
}
__device__ __forceinline__ void hyena_trivial(const bf16_t* uT, bf16_t* zT) {
    for (size_t i = (size_t)blockIdx.x * 512 + TIDX(); i < (size_t)512 * T; i += (size_t)gridDim.x * 512) {
        zT[i] = f2bf(bf2f(uT[i]) * bf2f(uT[i + (size_t)512 * T]) * bf2f(uT[i + (size_t)1024 * T])); }
}
__device__ __forceinline__ void conv8(const bf16_t* row, int t0, float w0, float w1, float w2, float bb, float (&o)[8]) {
    const u32x4 u = *(const u32x4*)(row + t0);
    const float pv = t0 > 0 ? bf2f(row[t0 - 1]) : 0.f, nx = (t0 + 8 < SEQ) ? bf2f(row[t0 + 8]) : 0.f;
    const float x[10] = {pv, bflo(u.x), bfhi(u.x), bflo(u.y), bfhi(u.y), bflo(u.z), bfhi(u.z), bflo(u.w), bfhi(u.w), nx};
#pragma unroll
    for (int m = 0; m < 8; ++m) o[m] = w0 * x[m] + w1 * x[m + 1] + w2 * x[m + 2] + bb;
}
__device__ __forceinline__ void hyena_phase(LAS unsigned char* lds, const bf16_t* uT, const f32x2* Kf, const float* cw, const float* cb, const float* bias_d, bf16_t* zT) {
    const int tid = TIDX();
    LAS f32x2* X = (LAS f32x2*)lds; LAS f32x2* tw = (LAS f32x2*)(lds + FFT_TW_OFF);
    build_tw(tw);
    const int t0 = tid * 8;
    for (int item = blockIdx.x * 4; item < 2048; item = ((item & 3) == 3) ? (item - 3 + 4 * (int)gridDim.x) : (item + 1)) {
        const int c = item >> 2, pr = item & 3;
        const size_t bo0 = (size_t)(pr * 2) * SEQ, bo1 = bo0 + SEQ;
        const bf16_t* r1 = uT + (size_t)c * T; const bf16_t* r2 = uT + (size_t)(512 + c) * T; const bf16_t* r3 = uT + (size_t)(1024 + c) * T;
        const float a0 = cw[c], a1 = cw[1536 + c], a2 = cw[3072 + c], ab = cb[c];
        const float b0 = cw[512 + c], b1 = cw[1536 + 512 + c], b2 = cw[3072 + 512 + c], bb = cb[512 + c];
        const float v0 = cw[1024 + c], v1 = cw[1536 + 1024 + c], v2 = cw[3072 + 1024 + c], vb = cb[1024 + c];
        const float d0 = bias_d[c], d1 = bias_d[512 + c];
        float va[8], vbt[8];
        conv8(r3 + bo0, t0, v0, v1, v2, vb, va); conv8(r3 + bo1, t0, v0, v1, v2, vb, vbt);
#pragma unroll
        for (int m = 0; m < 8; ++m) { X[FPAD(t0 + m)] = mk2(va[m], vbt[m]); X[FPAD(4096 + t0 + m)] = mk2(0.f, 0.f); }
        __syncthreads();
        fft_fwd3(X, tw); fft_mid(X, Kf + (size_t)c * 8192); fft_inv3(X, tw);
        f32x2 z2[8];
        { float xa[8], xb[8];
          conv8(r1 + bo0, t0, a0, a1, a2, ab, xa); conv8(r1 + bo1, t0, a0, a1, a2, ab, xb);
#pragma unroll
          for (int m = 0; m < 8; ++m) { const f32x2 y = X[FPAD(t0 + m)]; z2[m] = mk2(xa[m] * (y.x + d0 * va[m]), xb[m] * (y.y + d0 * vbt[m])); } }
        __syncthreads();
#pragma unroll
        for (int m = 0; m < 8; ++m) { X[FPAD(t0 + m)] = z2[m]; X[FPAD(4096 + t0 + m)] = mk2(0.f, 0.f); }
        __syncthreads();
        fft_fwd3(X, tw); fft_mid(X, Kf + (size_t)(512 + c) * 8192); fft_inv3(X, tw);
        { float xa[8], xb[8]; float oa[8], ob[8];
          conv8(r2 + bo0, t0, b0, b1, b2, bb, xa); conv8(r2 + bo1, t0, b0, b1, b2, bb, xb);
#pragma unroll
          for (int m = 0; m < 8; ++m) { const f32x2 y = X[FPAD(t0 + m)]; oa[m] = xa[m] * (y.x + d1 * z2[m].x); ob[m] = xb[m] * (y.y + d1 * z2[m].y); }
          u32x4 w; w.x = pk2(oa[0], oa[1]); w.y = pk2(oa[2], oa[3]); w.z = pk2(oa[4], oa[5]); w.w = pk2(oa[6], oa[7]);
          *(u32x4*)(zT + (size_t)c * T + bo0 + t0) = w;
          w.x = pk2(ob[0], ob[1]); w.y = pk2(ob[2], ob[3]); w.z = pk2(ob[4], ob[5]); w.w = pk2(ob[6], ob[7]);
          *(u32x4*)(zT + (size_t)c * T + bo1 + t0) = w; }
        __syncthreads();
    }
}
struct RwP { const bf16_t* urw; const float* mu; const float* w0; const float* a0; const float* k_k; const float* k_a; const float* r_k;
             const bf16_t* w2t; const bf16_t* a2t; const bf16_t* g2t;
             bf16_t *r, *k, *v, *kk, *af, *ab, *lwf, *lwb, *g; float* bonus; };
__device__ __forceinline__ float4 shiftq(const bf16_t* urw, int t, int tl, int sc, const float* mu) {
    const u32x2 u = *(const u32x2*)(urw + (size_t)t * 1952 + sc);
    u32x2 p = {0u, 0u}, n = {0u, 0u};
    if (tl > 0) p = *(const u32x2*)(urw + (size_t)(t - 1) * 1952 + sc);
    if (tl < SEQ - 1) n = *(const u32x2*)(urw + (size_t)(t + 1) * 1952 + sc);
    const float4 m0 = *(const float4*)(mu + sc), m1 = *(const float4*)(mu + 1952 + sc);
    float4 o; float uu, pp, nn;
    uu = bflo(u.x); pp = bflo(p.x); nn = bflo(n.x); o.x = uu + m0.x * (pp - uu) + m1.x * (nn - uu);
    uu = bfhi(u.x); pp = bfhi(p.x); nn = bfhi(n.x); o.y = uu + m0.y * (pp - uu) + m1.y * (nn - uu);
    uu = bflo(u.y); pp = bflo(p.y); nn = bflo(n.y); o.z = uu + m0.z * (pp - uu) + m1.z * (nn - uu);
    uu = bfhi(u.y); pp = bfhi(p.y); nn = bfhi(n.y); o.w = uu + m0.w * (pp - uu) + m1.w * (nn - uu);
    return o;
}
__device__ __forceinline__ void shift8(const bf16_t* urw, int t, int tl, int sc, const float* mu, float (&o)[8]) {
    const u32x4 u = *(const u32x4*)(urw + (size_t)t * 1952 + sc);
    u32x4 p = {0u, 0u, 0u, 0u}, n = p;
    if (tl > 0) p = *(const u32x4*)(urw + (size_t)(t - 1) * 1952 + sc);
    if (tl < SEQ - 1) n = *(const u32x4*)(urw + (size_t)(t + 1) * 1952 + sc);
    const float4 m0a = *(const float4*)(mu + sc), m0b = *(const float4*)(mu + sc + 4), m1a = *(const float4*)(mu + 1952 + sc), m1b = *(const float4*)(mu + 1952 + sc + 4);
    const float u8[8] = {bflo(u.x), bfhi(u.x), bflo(u.y), bfhi(u.y), bflo(u.z), bfhi(u.z), bflo(u.w), bfhi(u.w)};
    const float p8[8] = {bflo(p.x), bfhi(p.x), bflo(p.y), bfhi(p.y), bflo(p.z), bfhi(p.z), bflo(p.w), bfhi(p.w)};
    const float n8[8] = {bflo(n.x), bfhi(n.x), bflo(n.y), bfhi(n.y), bflo(n.z), bfhi(n.z), bflo(n.w), bfhi(n.w)};
    const float m0[8] = {m0a.x, m0a.y, m0a.z, m0a.w, m0b.x, m0b.y, m0b.z, m0b.w}, m1[8] = {m1a.x, m1a.y, m1a.z, m1a.w, m1b.x, m1b.y, m1b.z, m1b.w};
#pragma unroll
    for (int i = 0; i < 8; ++i) o[i] = u8[i] + m0[i] * (p8[i] - u8[i]) + m1[i] * (n8[i] - u8[i]);
}
__device__ __forceinline__ void ld8f(const float* p, float (&o)[8]) { const float4 a = *(const float4*)p, b = *(const float4*)(p + 4); o[0] = a.x; o[1] = a.y; o[2] = a.z; o[3] = a.w; o[4] = b.x; o[5] = b.y; o[6] = b.z; o[7] = b.w; }
__device__ __forceinline__ void st8bf(bf16_t* p, const float (&v)[8]) { u32x4 o; o.x = pk2(v[0], v[1]); o.y = pk2(v[2], v[3]); o.z = pk2(v[4], v[5]); o.w = pk2(v[6], v[7]); *(u32x4*)p = o; }
__device__ __forceinline__ void st4bf(bf16_t* p, float a, float b, float c, float d) { u32x2 o; o.x = pk2(a, b); o.y = pk2(c, d); *(u32x2*)p = o; }
__device__ __forceinline__ void rwprep_phase(LAS unsigned char* lds, const RwP P) {
    const int tid = TIDX(), lane = tid & 63, hw = tid >> 6, fr = lane & 15, fq = lane >> 4;
    LAS bf16_t* At = (LAS bf16_t*)lds;
    for (int tt = blockIdx.x; tt < T / 16; tt += gridDim.x) {
        const int t0 = tt * 16;
        __syncthreads();
#pragma unroll
        for (int it_ = 0; it_ < 2; ++it_) { const int e = tid + it_ * 512;
            if (e < 16 * 52) {
                const int tk = e / 52, col = (e - tk * 52) * 8, t = t0 + tk, tl = t & (SEQ - 1), sc = 1536 + col;
                const u32x4 uu = *(const u32x4*)(P.urw + (size_t)t * 1952 + sc);
                u32x4 pp = {0u, 0u, 0u, 0u}, nn = pp;
                if (tl > 0) pp = *(const u32x4*)(P.urw + (size_t)(t - 1) * 1952 + sc);
                if (tl < SEQ - 1) nn = *(const u32x4*)(P.urw + (size_t)(t + 1) * 1952 + sc);
                const float4 m0a = *(const float4*)(P.mu + sc), m0b = *(const float4*)(P.mu + sc + 4), m1a = *(const float4*)(P.mu + 1952 + sc), m1b = *(const float4*)(P.mu + 1952 + sc + 4);
                const float u8[8] = {bflo(uu.x), bfhi(uu.x), bflo(uu.y), bfhi(uu.y), bflo(uu.z), bfhi(uu.z), bflo(uu.w), bfhi(uu.w)};
                const float p8[8] = {bflo(pp.x), bfhi(pp.x), bflo(pp.y), bfhi(pp.y), bflo(pp.z), bfhi(pp.z), bflo(pp.w), bfhi(pp.w)};
                const float n8[8] = {bflo(nn.x), bfhi(nn.x), bflo(nn.y), bfhi(nn.y), bflo(nn.z), bfhi(nn.z), bflo(nn.w), bfhi(nn.w)};
                const float m0[8] = {m0a.x, m0a.y, m0a.z, m0a.w, m0b.x, m0b.y, m0b.z, m0b.w}, m1[8] = {m1a.x, m1a.y, m1a.z, m1a.w, m1b.x, m1b.y, m1b.z, m1b.w};
                float x8[8];
#pragma unroll
                for (int i = 0; i < 8; ++i) { float x = u8[i] + m0[i] * (p8[i] - u8[i]) + m1[i] * (n8[i] - u8[i]);
                    if (col < 128) { const float e2 = __expf(2.f * x); x = 1.f - 2.f * __builtin_amdgcn_rcpf(e2 + 1.f); } else if (col >= 256) x = sigm(x);
                    x8[i] = x; }
                u32x4 w; w.x = pk2(x8[0], x8[1]); w.y = pk2(x8[2], x8[3]); w.z = pk2(x8[4], x8[5]); w.w = pk2(x8[6], x8[7]);
                *(LAS u32x4*)(At + tk * 424 + col) = w;
            }
        }
        __syncthreads();
        const int t = t0 + fr, tl = t & (SEQ - 1);
#define AFR(ks) (*(const LAS bf16x8*)(At + fr * 424 + (ks) * 32 + fq * 8))
        float bon = 0.f;
#pragma unroll 1
        for (int pp = 0; pp < 2; ++pp) {
            const int c8 = hw * 64 + pp * 32 + 8 * fq;
            const int ncol0 = hw * 64 + pp * 32 + 8 * (fr >> 2) + (fr & 3), ncol1 = ncol0 + 4;
            f32x4 cwf0 = {0.f, 0.f, 0.f, 0.f}, cwb0 = cwf0, caf0 = cwf0, cab0 = cwf0, cg0 = cwf0, cwf1 = cwf0, cwb1 = cwf0, caf1 = cwf0, cab1 = cwf0, cg1 = cwf0;
#pragma unroll
            for (int kk2 = 0; kk2 < 2; ++kk2) { const int ko = kk2 * 32 + fq * 8;
                cwf0 = __builtin_amdgcn_mfma_f32_16x16x32_bf16(*(const bf16x8*)(P.w2t + (size_t)ncol0 * 64 + ko), AFR(0 + kk2), cwf0, 0, 0, 0);
                cwf1 = __builtin_amdgcn_mfma_f32_16x16x32_bf16(*(const bf16x8*)(P.w2t + (size_t)ncol1 * 64 + ko), AFR(0 + kk2), cwf1, 0, 0, 0);
                cwb0 = __builtin_amdgcn_mfma_f32_16x16x32_bf16(*(const bf16x8*)(P.w2t + (size_t)(512 + ncol0) * 64 + ko), AFR(2 + kk2), cwb0, 0, 0, 0);
                cwb1 = __builtin_amdgcn_mfma_f32_16x16x32_bf16(*(const bf16x8*)(P.w2t + (size_t)(512 + ncol1) * 64 + ko), AFR(2 + kk2), cwb1, 0, 0, 0);
                caf0 = __builtin_amdgcn_mfma_f32_16x16x32_bf16(*(const bf16x8*)(P.a2t + (size_t)ncol0 * 64 + ko), AFR(4 + kk2), caf0, 0, 0, 0);
                caf1 = __builtin_amdgcn_mfma_f32_16x16x32_bf16(*(const bf16x8*)(P.a2t + (size_t)ncol1 * 64 + ko), AFR(4 + kk2), caf1, 0, 0, 0);
                cab0 = __builtin_amdgcn_mfma_f32_16x16x32_bf16(*(const bf16x8*)(P.a2t + (size_t)(512 + ncol0) * 64 + ko), AFR(6 + kk2), cab0, 0, 0, 0);
                cab1 = __builtin_amdgcn_mfma_f32_16x16x32_bf16(*(const bf16x8*)(P.a2t + (size_t)(512 + ncol1) * 64 + ko), AFR(6 + kk2), cab1, 0, 0, 0);
            }
#pragma unroll
            for (int kk5 = 0; kk5 < 5; ++kk5) { const int ko = kk5 * 32 + fq * 8;
                cg0 = __builtin_amdgcn_mfma_f32_16x16x32_bf16(*(const bf16x8*)(P.g2t + (size_t)ncol0 * 160 + ko), AFR(8 + kk5), cg0, 0, 0, 0);
                cg1 = __builtin_amdgcn_mfma_f32_16x16x32_bf16(*(const bf16x8*)(P.g2t + (size_t)ncol1 * 160 + ko), AFR(8 + kk5), cg1, 0, 0, 0); }
            float rr[8], kv[8], vv[8];
            shift8(P.urw, t, tl, c8, P.mu, rr); shift8(P.urw, t, tl, 512 + c8, P.mu, kv); shift8(P.urw, t, tl, 1024 + c8, P.mu, vv);
            float w0f_[8], w0b_[8], a0f_[8], a0b_[8], ka_[8], rk_[8];
            ld8f(P.w0 + c8, w0f_); ld8f(P.w0 + 512 + c8, w0b_); ld8f(P.a0 + c8, a0f_); ld8f(P.a0 + 512 + c8, a0b_); ld8f(P.k_a + c8, ka_); ld8f(P.r_k + c8, rk_);
            const float xwf[8] = {cwf0[0], cwf0[1], cwf0[2], cwf0[3], cwf1[0], cwf1[1], cwf1[2], cwf1[3]}, xwb[8] = {cwb0[0], cwb0[1], cwb0[2], cwb0[3], cwb1[0], cwb1[1], cwb1[2], cwb1[3]};
            const float xaf[8] = {caf0[0], caf0[1], caf0[2], caf0[3], caf1[0], caf1[1], caf1[2], caf1[3]}, xab[8] = {cab0[0], cab0[1], cab0[2], cab0[3], cab1[0], cab1[1], cab1[2], cab1[3]};
            float lwf_[8], lwb_[8], aaf[8], aab[8];
#pragma unroll
            for (int j = 0; j < 8; ++j) {
                const float xf = w0f_[j] + xwf[j], xb = w0b_[j] + xwb[j];
                lwf_[j] = -__expf(-__logf(1.f + __expf(-xf)) - 0.5f); lwb_[j] = -__expf(-__logf(1.f + __expf(-xb)) - 0.5f);
                aaf[j] = sigm(a0f_[j] + xaf[j]); aab[j] = sigm(a0b_[j] + xab[j]);
                const float kdf = kv[j] * (1.f + (aaf[j] - 1.f) * ka_[j]), kdb = kv[j] * (1.f + (aab[j] - 1.f) * ka_[j]);
                bon += rr[j] * (kdf + kdb) * rk_[j];
            }
            const size_t off = (size_t)t * 512 + c8;
            st8bf(P.r + off, rr); st8bf(P.k + off, kv); st8bf(P.v + off, vv); st8bf(P.af + off, aaf); st8bf(P.ab + off, aab); st8bf(P.lwf + off, lwf_); st8bf(P.lwb + off, lwb_);
            { const float gg[8] = {cg0[0], cg0[1], cg0[2], cg0[3], cg1[0], cg1[1], cg1[2], cg1[3]}; st8bf(P.g + off, gg); }
        }
        bon += __shfl_xor(bon, 16); bon += __shfl_xor(bon, 32);
        if (fq == 0) P.bonus[(size_t)t * 8 + hw] = bon;
    }
}
__device__ __forceinline__ void scan_phase(LAS unsigned char* lds, const RwP P, bf16_t* yf, bf16_t* yb) {
    const int tid = TIDX(), cgx = tid & 15;
    for (int item = blockIdx.x; item < 256; item += gridDim.x) {
        const int half = item & 1, seq = item >> 1, dir = seq >> 6, b = (seq >> 3) & 7, h = seq & 7;
        const bf16_t* aA = dir ? P.ab : P.af; const bf16_t* lwA = dir ? P.lwb : P.lwf; bf16_t* yA = dir ? yb : yf;
        const float4 ka4 = *(const float4*)(P.k_a + h * 64 + cgx * 4), kkc4 = *(const float4*)(P.k_k + h * 64 + cgx * 4);
        __syncthreads();
#define SC_STAGE(chunk, step_, buf) do { const int sidx_ = (chunk) * 32 + (step_); const int t_ = dir ? (SEQ - 1 - sidx_) : sidx_; const size_t off_ = ((size_t)(b * SEQ + t_)) * 512 + h * 64 + cgx * 4; \
        const u32x2 Lr = *(const u32x2*)(P.r + off_), Lk = *(const u32x2*)(P.k + off_), Lv = *(const u32x2*)(P.v + off_), La = *(const u32x2*)(aA + off_), Llw = *(const u32x2*)(lwA + off_); \
        LAS f32x4* base_ = (LAS f32x4*)(lds + (buf) * 49152 + (step_) * 1536); \
        const float4 r4 = make_float4(bflo(Lr.x), bfhi(Lr.x), bflo(Lr.y), bfhi(Lr.y)), k4 = make_float4(bflo(Lk.x), bfhi(Lk.x), bflo(Lk.y), bfhi(Lk.y)), v4 = make_float4(bflo(Lv.x), bfhi(Lv.x), bflo(Lv.y), bfhi(Lv.y)); \
        float4 kk4 = make_float4(k4.x * kkc4.x, k4.y * kkc4.y, k4.z * kkc4.z, k4.w * kkc4.w); \
        { const float kin_ = 1.f / fmaxf(sqrtf(row16_allsum(kk4.x * kk4.x + kk4.y * kk4.y + kk4.z * kk4.z + kk4.w * kk4.w)), 1e-12f); kk4.x *= kin_; kk4.y *= kin_; kk4.z *= kin_; kk4.w *= kin_; } \
        const float4 a4 = make_float4(bflo(La.x), bfhi(La.x), bflo(La.y), bfhi(La.y)), l4 = make_float4(bflo(Llw.x), bfhi(Llw.x), bflo(Llw.y), bfhi(Llw.y)); \
        base_[cgx] = (f32x4){__expf(l4.x), __expf(l4.y), __expf(l4.z), __expf(l4.w)}; \
        base_[16 + cgx] = (f32x4){kk4.x * a4.x, kk4.y * a4.y, kk4.z * a4.z, kk4.w * a4.w}; \
        base_[32 + cgx] = (f32x4){k4.x * (1.f + (a4.x - 1.f) * ka4.x), k4.y * (1.f + (a4.y - 1.f) * ka4.y), k4.z * (1.f + (a4.z - 1.f) * ka4.z), k4.w * (1.f + (a4.w - 1.f) * ka4.w)}; \
        base_[48 + cgx] = (f32x4){kk4.x, kk4.y, kk4.z, kk4.w}; base_[64 + cgx] = (f32x4){r4.x, r4.y, r4.z, r4.w}; base_[80 + cgx] = (f32x4){v4.x, v4.y, v4.z, v4.w}; } while (0)
#define SC_YSTORE(chunk, p_) do { const int st_ = (p_) >> 4, rq_ = (p_) & 15; const int sidx_ = (chunk) * 32 + st_; const int t_ = dir ? (SEQ - 1 - sidx_) : sidx_; \
        const LAS float* yb_ = (const LAS float*)(lds + 98304 + ((chunk) & 1) * 4096); \
        *(unsigned*)(yA + ((size_t)(b * SEQ + t_)) * 512 + h * 64 + half * 32 + 2 * rq_) = pk2(yb_[st_ * 32 + 2 * rq_], yb_[st_ * 32 + 2 * rq_ + 1]); } while (0)
        { const int st0_ = tid >> 4; SC_STAGE(0, st0_, 0); }
        __syncthreads();
        const int rp = tid >> 4;
        const int ls = (tid - 256) >> 4;
        f32x2 a01 = {0.f, 0.f}, a23 = a01, b01 = a01, b23 = a01;
        for (int c = 0; c < 128; ++c) {
            const LAS unsigned char* vb = lds + (c & 1) * 49152;
            LAS float* ybuf = (LAS float*)(lds + 98304 + (c & 1) * 4096);
            if (tid < 256) {
                __builtin_amdgcn_s_setprio(3);
#define SC_LOAD(W, QK, DK, KK, R, VV, st_) do { const LAS f32x4* p_ = (const LAS f32x4*)(vb + (st_) * 1536); W = p_[cgx]; QK = p_[16 + cgx]; DK = p_[32 + cgx]; KK = p_[48 + cgx]; R = p_[64 + cgx]; \
        VV = *(const LAS f32x2*)(vb + (st_) * 1536 + (320 + half * 32 + 2 * rp) * 4); } while (0)
#define SC_STEP(W, QK, DK, KK, R, VV, st_) do { \
        f32x2 pa = a01 * KK.xy + a23 * KK.zw, pb = b01 * KK.xy + b23 * KK.zw; \
        float pza = pa.x + pa.y, pzb = pb.x + pb.y; \
        float z_ = zk + dpp_f<0x128>(zs);                   \
        pza += dpp_f<0x128>(pza); pzb += dpp_f<0x128>(pzb); z_ += dpp_f<0xB1>(z_); \
        pza += dpp_f<0x124>(pza); pzb += dpp_f<0x124>(pzb); z_ += dpp_f<0x4E>(z_); \
        pza += dpp_f<0x122>(pza); pzb += dpp_f<0x122>(pzb); z_ += dpp_f<0x141>(z_); \
        pza += dpp_f<0x121>(pza); pzb += dpp_f<0x121>(pzb); \
        ydst[((st_) > 0 ? (st_) - 1 : 0) * 32] = z_;                        \
        f32x2 sa2; sa2.x = -pza; sa2.y = -pza; f32x2 sb2; sb2.x = -pzb; sb2.y = -pzb; \
        f32x2 va; va.x = VV.x; va.y = VV.x; f32x2 vb2; vb2.x = VV.y; vb2.y = VV.y; \
        a01 = a01 * W.xy + sa2 * QK.xy + va * DK.xy; a23 = a23 * W.zw + sa2 * QK.zw + va * DK.zw; \
        b01 = b01 * W.xy + sb2 * QK.xy + vb2 * DK.xy; b23 = b23 * W.zw + sb2 * QK.zw + vb2 * DK.zw; \
        f32x2 ya = a01 * R.xy + a23 * R.zw, yb2 = b01 * R.xy + b23 * R.zw; \
        const float y0 = ya.x + ya.y, y1 = yb2.x + yb2.y; \
        zk = yhi ? y1 : y0; zs = yhi ? y0 : y1; } while (0)
                const bool yhi = (cgx & 8) != 0;
                LAS float* ydst = ((cgx & 7) == 0) ? (ybuf + 2 * rp + (yhi ? 1 : 0)) : ((LAS float*)(lds + 106496) + tid);
                float zk = 0.f, zs = 0.f;
                f32x4 w0, q0, d0, k0, r0, w1, q1, d1, k1, r1, w2, q2, d2, k2, r2, w3, q3, d3, k3, r3; f32x2 v0, v1, v2, v3;
                SC_LOAD(w0, q0, d0, k0, r0, v0, 0); SC_LOAD(w1, q1, d1, k1, r1, v1, 1); SC_LOAD(w2, q2, d2, k2, r2, v2, 2);
#pragma unroll
                for (int st = 0; st < 32; st += 4) {
                    SC_LOAD(w3, q3, d3, k3, r3, v3, st + 3);
                    SC_STEP(w0, q0, d0, k0, r0, v0, st);
                    SC_LOAD(w0, q0, d0, k0, r0, v0, st + 4);
                    SC_STEP(w1, q1, d1, k1, r1, v1, st + 1);
                    SC_LOAD(w1, q1, d1, k1, r1, v1, st + 5);
                    SC_STEP(w2, q2, d2, k2, r2, v2, st + 2);
                    SC_LOAD(w2, q2, d2, k2, r2, v2, st + 6);
                    SC_STEP(w3, q3, d3, k3, r3, v3, st + 3);
                }
                { float z_ = zk + dpp_f<0x128>(zs); z_ += dpp_f<0xB1>(z_); z_ += dpp_f<0x4E>(z_); z_ += dpp_f<0x141>(z_); ydst[31 * 32] = z_; }
#undef SC_LOAD
#undef SC_STEP
                __builtin_amdgcn_s_setprio(0);
            } else {
                if (c + 1 < 128) { SC_STAGE(c + 1, ls, (c + 1) & 1); SC_STAGE(c + 1, ls + 16, (c + 1) & 1); }
                if (c > 0) { SC_YSTORE(c - 1, tid - 256); SC_YSTORE(c - 1, tid); }
            }
            __syncthreads();
        }
        if (tid >= 256) { SC_YSTORE(127, tid - 256); SC_YSTORE(127, tid); }
#undef SC_STAGE
#undef SC_YSTORE
    }
}
__device__ __forceinline__ void rwpost_phase(const bf16_t* __restrict__ yf, const bf16_t* __restrict__ yb, const bf16_t* __restrict__ v, const bf16_t* __restrict__ g, const float* __restrict__ bonus, const float* __restrict__ ln_w, const float* __restrict__ ln_b, bf16_t* __restrict__ Acat) {
    const int lane = TIDX() & 63, wid = TIDX() >> 6;
#pragma unroll 4
    for (int t = blockIdx.x * 8 + wid; t < T; t += gridDim.x * 8) {
        const size_t off = (size_t)t * 512 + lane * 8;
        const u32x4 a4 = *(const u32x4*)(yf + off), b4 = *(const u32x4*)(yb + off), v4 = *(const u32x4*)(v + off), g4 = *(const u32x4*)(g + off);
        float y[8] = {bflo(a4.x) + bflo(b4.x), bfhi(a4.x) + bfhi(b4.x), bflo(a4.y) + bflo(b4.y), bfhi(a4.y) + bfhi(b4.y), bflo(a4.z) + bflo(b4.z), bfhi(a4.z) + bfhi(b4.z), bflo(a4.w) + bflo(b4.w), bfhi(a4.w) + bfhi(b4.w)};
        const float vv[8] = {bflo(v4.x), bfhi(v4.x), bflo(v4.y), bfhi(v4.y), bflo(v4.z), bfhi(v4.z), bflo(v4.w), bfhi(v4.w)};
        const float gg[8] = {bflo(g4.x), bfhi(g4.x), bflo(g4.y), bfhi(g4.y), bflo(g4.z), bfhi(g4.z), bflo(g4.w), bfhi(g4.w)};
        float s = 0.f;
#pragma unroll
        for (int i = 0; i < 8; ++i) s += y[i];
        s += __shfl_xor(s, 1); s += __shfl_xor(s, 2); s += __shfl_xor(s, 4);
        const float mean = s * (1.f / 64.f); float q = 0.f;
#pragma unroll
        for (int i = 0; i < 8; ++i) { y[i] -= mean; q += y[i] * y[i]; }
        q += __shfl_xor(q, 1); q += __shfl_xor(q, 2); q += __shfl_xor(q, 4);
        const float rstd = rsqrtf(q * (1.f / 64.f) + 64e-5f);
        const float bon = bonus[(size_t)t * 8 + (lane >> 3)];
        float o[8];
#pragma unroll
        for (int i = 0; i < 8; ++i) { const int c = lane * 8 + i; o[i] = ((y[i] * rstd) * ln_w[c] + ln_b[c] + bon * vv[i]) * gg[i]; }
        u32x4 w; w.x = pk2(o[0], o[1]); w.y = pk2(o[2], o[3]); w.z = pk2(o[4], o[5]); w.w = pk2(o[6], o[7]);
        *(u32x4*)(Acat + (size_t)t * DM + 512 + lane * 8) = w;
    }
}
__device__ __forceinline__ void ztrans_phase(LAS unsigned char* lds, const bf16_t* zT, bf16_t* Acat, int ldo) {
    const int tid = TIDX();
    LAS bf16_t* tile = (LAS bf16_t*)lds;
    for (int it = blockIdx.x; it < 4096; it += gridDim.x) {
        const int c0 = (it & 7) * 64, t0 = (it >> 3) * 64;
        __syncthreads();
        { const int i = tid >> 3, j8 = tid & 7; const u32x4 v = *(const u32x4*)(zT + (size_t)(c0 + i) * T + t0 + j8 * 8); *(LAS u32x4*)(tile + i * 72 + j8 * 8) = v; }
        __syncthreads();
        { const int j = tid >> 3, i8 = tid & 7; unsigned short e[8];
#pragma unroll
          for (int q = 0; q < 8; ++q) e[q] = tile[(i8 * 8 + q) * 72 + j];
          u32x4 w; w.x = e[0] | ((unsigned)e[1] << 16); w.y = e[2] | ((unsigned)e[3] << 16); w.z = e[4] | ((unsigned)e[5] << 16); w.w = e[6] | ((unsigned)e[7] << 16);
          *(u32x4*)(Acat + (size_t)(t0 + j) * ldo + c0 + i8 * 8) = w; }
    }
}

#ifndef EXP_LDA
#define EXP_LDA 1024
#endif
#define XB_TMO      128
#define XB_XCNT(j)  (256  + 64 * (j))
#define XB_XSUB(j)  (1280 + 64 * (j))
#define XB_XGEN(j)  (2304 + 64 * (j))
#define XB_TOP      3328
#define XB_TOPGEN   3392
#define XCD_BAR_WORDS 3456
#define XB_SPIN_CAP (1u << 18)

__device__ __forceinline__ unsigned xb_ld(unsigned* p)              { return __hip_atomic_load(p, __ATOMIC_RELAXED, __HIP_MEMORY_SCOPE_AGENT); }
__device__ __forceinline__ unsigned xb_add(unsigned* p, unsigned v) { return __hip_atomic_fetch_add(p, v, __ATOMIC_RELAXED, __HIP_MEMORY_SCOPE_AGENT); }
__device__ __forceinline__ unsigned xb_xcc_id() { return (unsigned)__builtin_amdgcn_s_getreg((3 << 11) | 20) & 0xFu; }
#define XB_SPIN(cond, bar) do { unsigned _sp = 0; while (cond) { __builtin_amdgcn_s_sleep(1); \
    if ((++_sp & 255u) == 0u) { if (xb_ld(&(bar)[XB_TMO])) break; if (_sp > XB_SPIN_CAP) { atomicAdd(&(bar)[XB_TMO], 1u); break; } } } } while (0)

struct XcdBarrier {
    unsigned* bar; unsigned x;
    volatile LAS unsigned* st;
};

__device__ __forceinline__ XcdBarrier xcd_barrier_post(unsigned* bar, volatile LAS unsigned* st) {
    XcdBarrier b; b.bar = bar; b.x = xb_xcc_id(); b.st = st;
    if (threadIdx.x == 0) (void)xb_add(&bar[XB_XCNT(b.x)], 1u);
    return b;
}
__device__ __forceinline__ void xcd_barrier_complete(unsigned* bar, unsigned x, unsigned& nloc, unsigned& nx) {
    const unsigned G = gridDim.x * gridDim.y * gridDim.z;
    unsigned sum, cnt, mine, sp = 0u;
    for (;;) {
        sum = 0u; cnt = 0u; mine = 0u;
#pragma unroll
        for (unsigned j = 0; j < 16; ++j) { const unsigned c = xb_ld(&bar[XB_XCNT(j)]); sum += c; cnt += (c > 0u) ? 1u : 0u; mine = (j == x) ? c : mine; }
        if (sum == G) break;
        __builtin_amdgcn_s_sleep(1);
        if ((++sp & 255u) == 0u) { if (xb_ld(&bar[XB_TMO])) break; if (sp > XB_SPIN_CAP) { atomicAdd(&bar[XB_TMO], 1u); break; } }
    }
    nloc = mine > 0u ? mine : 1u; nx = cnt > 0u ? cnt : 1u;
}

__device__ __forceinline__ void xcd_barrier(const XcdBarrier& b) {
    asm volatile("s_waitcnt vmcnt(0)" ::: "memory");
    __syncthreads();
    if (threadIdx.x == 0) {
        unsigned* bar = b.bar;
        __builtin_amdgcn_s_waitcnt(0);
        unsigned nloc = b.st[0], nx = b.st[1];
        if (nloc == 0u) { xcd_barrier_complete(bar, b.x, nloc, nx); b.st[0] = nloc; b.st[1] = nx; }
        const unsigned old = xb_add(&bar[XB_XSUB(b.x)], 1u);
        const unsigned gen = old / nloc;
        if (old + 1u == (gen + 1u) * nloc) {
            __builtin_amdgcn_fence(__ATOMIC_RELEASE, "agent");
            asm volatile("s_waitcnt vmcnt(0)" ::: "memory");
            const unsigned og = xb_add(&bar[XB_TOP], 1u);
            const unsigned tg = og / nx;
            if (og + 1u == (tg + 1u) * nx) xb_add(&bar[XB_TOPGEN], 1u);
            else XB_SPIN(xb_ld(&bar[XB_TOPGEN]) == tg, bar);
            __builtin_amdgcn_fence(__ATOMIC_ACQUIRE, "agent");
            xb_add(&bar[XB_XGEN(b.x)], 1u);
            asm volatile("s_waitcnt vmcnt(0)" ::: "memory");
        } else {
            XB_SPIN(xb_ld(&bar[XB_XGEN(b.x)]) == gen, bar);
            __builtin_amdgcn_fence(__ATOMIC_ACQUIRE, "agent");
            asm volatile("s_waitcnt vmcnt(0)" ::: "memory");
        }
    }
    __syncthreads();
}


#define GSYNC() xcd_barrier(xbar)
template <class T_> __device__ __forceinline__ T_* GP(T_* p) { return (T_*)(__attribute__((address_space(1))) T_*)p; }
#define GETA() (&a_param)
#define WSP(T_, off) ((T_*)(GP(GETA()->ws) + (off)))
__device__ __forceinline__ RwP make_rwp(const Args* a) {
    unsigned char* ws = GP(a->ws); bf16_t* WB = (bf16_t*)(ws + OFF_WBF);
    RwP P; P.urw = (bf16_t*)(ws + OFF_URW); P.mu = GP(a->in[18]); P.w0 = GP(a->in[19]); P.a0 = GP(a->in[21]); P.k_k = GP(a->in[24]); P.k_a = GP(a->in[25]); P.r_k = GP(a->in[26]);
    P.w2t = WB + W_W2T; P.a2t = WB + W_A2T; P.g2t = WB + W_G2T;
    P.r = (bf16_t*)(ws + OFF_R); P.k = (bf16_t*)(ws + OFF_K); P.v = (bf16_t*)(ws + OFF_V); P.kk = (bf16_t*)(ws + OFF_KK); P.af = (bf16_t*)(ws + OFF_AF); P.ab = (bf16_t*)(ws + OFF_AB);
    P.lwf = (bf16_t*)(ws + OFF_LWF); P.lwb = (bf16_t*)(ws + OFF_LWB); P.g = (bf16_t*)(ws + OFF_G); P.bonus = (float*)(ws + OFF_BONUS);
    return P;
}
__global__ void __launch_bounds__(512, 2) mega(Args a_param) {
    extern __shared__ __attribute__((aligned(16))) unsigned char lds_raw[];
    LAS unsigned char* lds = (LAS unsigned char*)lds_raw;
    cg::grid_group grid = cg::this_grid();
    volatile LAS unsigned* xst = (volatile LAS unsigned*)(lds + (LDS_BYTES - 16));
    if (threadIdx.x == 0) { xst[0] = 0u; xst[1] = 0u; }
    __syncthreads();
    const XcdBarrier xbar = xcd_barrier_post((unsigned*)(GP(a_param.ws) + OFF_BAR), xst);
    if (gridDim.x > 100000) grid.sync();
#ifdef DBL_P0
    for (int rep_ = 0; rep_ < 2; ++rep_)
#endif
    { const Args* a = GETA(); bf16_t* WB = (bf16_t*)(GP(a->ws) + OFF_WBF);
      cvt_wT_tiled(lds, GP(a->in[2]), 5632, WB + W_GU1, 5632, 1024, [](int n) { return gu_col(n); });
      cvt_wT_tiled(lds, GP(a->in[3]), 1024, WB + W_D1, 1024, 2816, [](int n) { return n; });
      cvt_wT_tiled(lds, GP(a->in[5]), 5536, WB + W_INHY, 1536, 1024, [](int n) { return n; });
      cvt_wT_tiled(lds, GP(a->in[5]), 5536, WB + W_INRW, 2048, 1024, [](int n) { return n < 1952 ? 1536 + n : -1; });
      cvt_wT_tiled(lds, GP(a->in[5]), 5536, WB + W_GT, 2048, 1024, [](int n) { return 3488 + n; });
      cvt_wT_tiled(lds, GP(a->in[17]), 1024, WB + W_HY, 1024, 512, [](int n) { return n; });
      cvt_wT_tiled(lds, GP(a->in[29]), 1024, WB + W_RW, 1024, 512, [](int n) { return n; });
      cvt_wT_tiled(lds, GP(a->in[30]), 1024, WB + W_O, 1024, 1024, [](int n) { return n; });
      cvt_wT_tiled(lds, GP(a->in[32]), 5632, WB + W_GU2, 5632, 1024, [](int n) { return gu_col(n); });
      cvt_wT_tiled(lds, GP(a->in[33]), 1024, WB + W_D2, 1024, 2816, [](int n) { return n; });
      cvt_wT(GP(a->in[20]), 512, WB + W_W2T, 512, 64, [](int n) { return n; });
      cvt_wT(GP(a->in[20]) + 64 * 512, 512, WB + W_W2T + 512 * 64, 512, 64, [](int n) { return n; });
      cvt_wT(GP(a->in[22]), 512, WB + W_A2T, 512, 64, [](int n) { return n; });
      cvt_wT(GP(a->in[22]) + 64 * 512, 512, WB + W_A2T + 512 * 64, 512, 64, [](int n) { return n; });
      cvt_wT(GP(a->in[23]), 512, WB + W_G2T, 512, 160, [](int n) { return n; });
      __syncthreads();
      norm_rows_bf16(GP(a->in[0]), GP(a->in[1]), (bf16_t*)(GP(a->ws) + OFF_A));
#ifdef DBL_NORM
      norm_rows_bf16(GP(a->in[0]), GP(a->in[1]), (bf16_t*)(GP(a->ws) + OFF_A));
#endif
#ifndef NO_MLP
      hy_mlp_phase(lds, GP(a->in[8]), GP(a->in[9]), GP(a->in[10]), GP(a->in[11]), GP(a->in[14]), (float*)(GP(a->ws) + OFF_MLP));
#endif
    }
    GSYNC();
    { const Args* a = GETA();
#ifndef NO_KRAW
      hy_kraw_phase(lds, GP(a->in[12]), GP(a->in[13]), GP(a->in[15]), (const float*)(GP(a->ws) + OFF_MLP), (float*)(GP(a->ws) + OFF_KRAW));
#ifdef DBL_KRAW
      hy_kraw_phase(lds, GP(a->in[12]), GP(a->in[13]), GP(a->in[15]), (const float*)(GP(a->ws) + OFF_MLP), (float*)(GP(a->ws) + OFF_KRAW));
#endif
#endif
      __syncthreads();
      EpiGU E; E.O = (bf16_t*)(GP(a->ws) + OFF_B);
      run_gemm(lds, (const bf16_t*)(GP(a->ws) + OFF_A), 1024, (const bf16_t*)(GP(a->ws) + OFF_WBF) + W_GU1, 1024, T, 5632, 1024, E);
#ifdef DBL_GU
      run_gemm(lds, (const bf16_t*)(GP(a->ws) + OFF_A), 1024, (const bf16_t*)(GP(a->ws) + OFF_WBF) + W_GU1, 1024, T, 5632, 1024, E);
#endif
      }
    GSYNC();
    { const Args* a = GETA();
      EpiResidT<0, 1> E; E.base = GP(a->in[0]); E.out = GP(a->out); E.scale = 0.5f;
      run_gemm(lds, (const bf16_t*)(GP(a->ws) + OFF_B), DFF, (const bf16_t*)(GP(a->ws) + OFF_WBF) + W_D1, DFF, T, 1024, DFF, E);
      __syncthreads();
#ifndef NO_FFT
      hy_filter_fft_phase(lds, (const float*)(GP(a->ws) + OFF_KRAW), (f32x2*)(GP(a->ws) + OFF_KF));
#ifdef DBL_FFT
      hy_filter_fft_phase(lds, (const float*)(GP(a->ws) + OFF_KRAW), (f32x2*)(GP(a->ws) + OFF_KF));
#endif
#endif
    }
    GSYNC();
#ifndef SKIP_MIXER
    { const Args* a = GETA(); norm_rows_bf16in((const bf16_t*)GP(a->out), GP(a->in[4]), (bf16_t*)(GP(a->ws) + OFF_A)); }
#ifdef DBL_NORM
    { const Args* a = GETA(); norm_rows_bf16in((const bf16_t*)GP(a->out), GP(a->in[4]), (bf16_t*)(GP(a->ws) + OFF_A)); }
#endif
    GSYNC();
    { const Args* a = GETA();
      EpiBf16<0> E1; E1.O = (bf16_t*)(GP(a->ws) + OFF_UTHY); E1.ldc = T; E1.ncols = T;
      run_gemm(lds, (const bf16_t*)(GP(a->ws) + OFF_WBF) + W_INHY, 1024, (const bf16_t*)(GP(a->ws) + OFF_A), 1024, 1536, T, 1024, E1); }
#ifndef EXP_SKIP_G3B
    { const Args* a = GETA();
      EpiBf16<0> E2; E2.O = (bf16_t*)(GP(a->ws) + OFF_URW); E2.ldc = 1952; E2.ncols = 1952;
      run_gemm(lds, (const bf16_t*)(GP(a->ws) + OFF_A), 1024, (const bf16_t*)(GP(a->ws) + OFF_WBF) + W_INRW, 1024, T, 2048, 1024, E2); }
#endif
    GSYNC();
#ifdef EXP8
    { const Args* a = GETA(); const bf16_t* uT_ = (const bf16_t*)(GP(a->ws) + OFF_UTHY); float* X_ = GP(a->out);
      for (size_t i = (size_t)blockIdx.x * 512 + TIDX(); i < (size_t)1024 * T; i += (size_t)gridDim.x * 512) { const size_t c = i / T, t = i % T; X_[t * DM + c] += bf2f(uT_[i]); } }
    GSYNC();
#else
#ifndef NO_HY

#ifndef SKIP_HY
#ifdef HY_TRIVIAL
    { const Args* a = GETA(); hyena_trivial((const bf16_t*)(GP(a->ws) + OFF_UTHY), (bf16_t*)(GP(a->ws) + OFF_ZT)); }
#else
    { const Args* a = GETA(); hyena_phase(lds, (const bf16_t*)(GP(a->ws) + OFF_UTHY), (const f32x2*)(GP(a->ws) + OFF_KF), GP(a->in[6]), GP(a->in[7]), GP(a->in[16]), (bf16_t*)(GP(a->ws) + OFF_ZT)); }
#ifdef DBL_HY
    { const Args* a = GETA(); hyena_phase(lds, (const bf16_t*)(GP(a->ws) + OFF_UTHY), (const f32x2*)(GP(a->ws) + OFF_KF), GP(a->in[6]), GP(a->in[7]), GP(a->in[16]), (bf16_t*)(GP(a->ws) + OFF_ZT)); }
#endif
#endif
#endif

#endif
    GSYNC();
#ifndef NO_PREP

#ifndef SKIP_RW
    { const Args* a = GETA(); rwprep_phase(lds, make_rwp(a)); }
#ifdef DBL_PREP
    { const Args* a = GETA(); rwprep_phase(lds, make_rwp(a)); }
#endif
#endif

#endif
    GSYNC();
#ifndef NO_SCAN

#ifndef SKIP_RW
    { const Args* a = GETA(); scan_phase(lds, make_rwp(a), (bf16_t*)(GP(a->ws) + OFF_YF), (bf16_t*)(GP(a->ws) + OFF_YB)); }
#ifdef DBL_SCAN
    { const Args* a = GETA(); scan_phase(lds, make_rwp(a), (bf16_t*)(GP(a->ws) + OFF_YF), (bf16_t*)(GP(a->ws) + OFF_YB)); }
#endif
#endif

#endif
    GSYNC();
    { const Args* a = GETA(); unsigned char* ws = GP(a->ws);

#ifndef SKIP_RW
      rwpost_phase((const bf16_t*)(ws + OFF_YF), (const bf16_t*)(ws + OFF_YB), (const bf16_t*)(ws + OFF_V), (const bf16_t*)(ws + OFF_G), (const float*)(ws + OFF_BONUS), GP(a->in[27]), GP(a->in[28]), (bf16_t*)(ws + OFF_ACAT));
#endif


#ifndef SKIP_HY
      ztrans_phase(lds, (const bf16_t*)(ws + OFF_ZT), (bf16_t*)(ws + OFF_ACAT), EXP_LDA);
#endif

#ifndef EXP4
      norm_rows_bf16in((const bf16_t*)GP(a->out), GP(a->in[4]), (bf16_t*)(ws + OFF_A));
#ifdef DBL_NORM
      norm_rows_bf16in((const bf16_t*)GP(a->out), GP(a->in[4]), (bf16_t*)(ws + OFF_A));
#endif
#endif
      }
    GSYNC();
#if !defined(EXP2) && !defined(EXP3)
    { const Args* a = GETA(); EpiBf16<1> E; E.O = (bf16_t*)(GP(a->ws) + OFF_GATES); E.ldc = 2048; E.ncols = 2048;
      run_gemm(lds, (const bf16_t*)(GP(a->ws) + OFF_A), 1024, (const bf16_t*)(GP(a->ws) + OFF_WBF) + W_GT, 1024, T, 2048, 1024, E); }
#endif
    GSYNC();
    { const Args* a = GETA(); EpiMerge<0> E; E.Mg = (bf16_t*)(GP(a->ws) + OFF_MERGED); E.gates = (const bf16_t*)(GP(a->ws) + OFF_GATES); E.goff = 0;
      run_gemm(lds, (const bf16_t*)(GP(a->ws) + OFF_ACAT), 1024, (const bf16_t*)(GP(a->ws) + OFF_WBF) + W_HY, 512, T, 1024, 512, E); }
    GSYNC();
    { const Args* a = GETA(); EpiMerge<1> E; E.Mg = (bf16_t*)(GP(a->ws) + OFF_MERGED); E.gates = (const bf16_t*)(GP(a->ws) + OFF_GATES); E.goff = 1024;
      run_gemm(lds, (const bf16_t*)(GP(a->ws) + OFF_ACAT) + 512, 1024, (const bf16_t*)(GP(a->ws) + OFF_WBF) + W_RW, 512, T, 1024, 512, E); }
    GSYNC();
    { const Args* a = GETA(); EpiResidT<1, 1> E; E.base = GP(a->out); E.out = GP(a->out); E.scale = 1.f;
      run_gemm(lds, (const bf16_t*)(GP(a->ws) + OFF_MERGED), 1024, (const bf16_t*)(GP(a->ws) + OFF_WBF) + W_O, 1024, T, 1024, 1024, E); }
    GSYNC();
#endif
#endif
    { const Args* a = GETA(); norm_rows_bf16in((const bf16_t*)GP(a->out), GP(a->in[31]), (bf16_t*)(GP(a->ws) + OFF_A)); }
#ifdef DBL_NORM
    { const Args* a = GETA(); norm_rows_bf16in((const bf16_t*)GP(a->out), GP(a->in[31]), (bf16_t*)(GP(a->ws) + OFF_A)); }
#endif
    GSYNC();
    { const Args* a = GETA(); EpiGU E; E.O = (bf16_t*)(GP(a->ws) + OFF_B);
      run_gemm(lds, (const bf16_t*)(GP(a->ws) + OFF_A), 1024, (const bf16_t*)(GP(a->ws) + OFF_WBF) + W_GU2, 1024, T, 5632, 1024, E); }
    GSYNC();
    { const Args* a = GETA(); EpiResidT<1, 1> E; E.base = GP(a->out); E.out = (bf16_t*)(GP(a->ws) + OFF_X3); E.scale = 0.5f;
      run_gemm(lds, (const bf16_t*)(GP(a->ws) + OFF_B), DFF, (const bf16_t*)(GP(a->ws) + OFF_WBF) + W_D2, DFF, T, 1024, DFF, E); }
    GSYNC();
#ifdef EXTRA_SYNCS
    for (int r_ = 0; r_ < 10; ++r_) { GSYNC(); }
#endif
    { const Args* a = GETA(); norm_rows_bf16_to_f32((const bf16_t*)(GP(a->ws) + OFF_X3), GP(a->in[34]), GP(a->out)); }
}

extern "C" void kernel_launch(void* const* d_in, const int* in_sizes, int n_in, void* d_out, int out_size, void* d_ws, size_t ws_size, hipStream_t stream) {
    static int grid = 0;
    if (grid == 0) {
        int dev = 0, cus = 0, per_cu = 0;
        (void)hipGetDevice(&dev); (void)hipDeviceGetAttribute(&cus, hipDeviceAttributeMultiprocessorCount, dev);
        (void)hipFuncSetAttribute((const void*)mega, hipFuncAttributeMaxDynamicSharedMemorySize, LDS_BYTES);
        (void)hipOccupancyMaxActiveBlocksPerMultiprocessor(&per_cu, (const void*)mega, 512, LDS_BYTES);
        (void)hipGetLastError();
        grid = cus > 0 ? cus : 256;
        if (n_in != 35 || ws_size < 512 * MiB) fprintf(stderr, "kernel_launch: unexpected n_in %d / ws %zu\n", n_in, ws_size);
    }
    (void)hipMemsetAsync((unsigned char*)d_ws + OFF_BAR, 0, XCD_BAR_WORDS * 4, stream);
    Args a{};
    for (int i = 0; i < 35; ++i) a.in[i] = (const float*)d_in[i];
    a.out = (float*)d_out; a.ws = (unsigned char*)d_ws;
    void* args[] = {&a};
    hipError_t e = hipLaunchCooperativeKernel((const void*)mega, dim3(grid), dim3(512), args, LDS_BYTES, stream);
    if (e != hipSuccess) fprintf(stderr, "cooperative launch failed: %s (grid %d)\n", hipGetErrorString(e), grid);
}
```

```cpp
#include <hip/hip_runtime.h>
#include <hip/hip_cooperative_groups.h>
#include <cstdio>
namespace cg = cooperative_groups;
#define LAS __attribute__((address_space(3)))
namespace pg8 {
#define PG8_LAS __attribute__((address_space(3)))
typedef unsigned short bf16_t;
typedef short bf16x8 __attribute__((ext_vector_type(8)));
typedef float f32x4 __attribute__((ext_vector_type(4)));
typedef unsigned u32x4 __attribute__((ext_vector_type(4)));
constexpr int BM = 256, BK = 64, HALF = 128, HTB = HALF * BK * 2, STAGE_BYTES = 8 * HTB, NXCD = 8, WGM = 8;
__host__ __device__ __forceinline__ int lds_byte(int r, int c) { const int st = (r >> 4) * 2 + (c >> 5), rr = r & 15, cc = c & 31, ob = rr * 64 + cc * 2; return st * 1024 + (ob ^ (((ob >> 9) & 1) << 5)); }
__host__ __device__ __forceinline__ void stage_rc(int b, int& R, int& C) { const int st = b / 1024, sb = b % 1024, swz = sb ^ (((sb >> 9) & 1) << 5); R = (st >> 1) * 16 + swz / 64; C = (st & 1) * 32 + (swz % 64) / 2; }
__host__ __device__ __forceinline__ int perm32(int rho) { const int n = rho >> 4, i = rho & 15; return 8 * (i >> 2) + 4 * n + (i & 3); }
struct Unit { int pm, pn; };
struct Gemm { const bf16_t* A; const bf16_t* Bt; int M, N, K, lda, ldb; };
struct StaticOrder {
    int nM, nN, nwg, G, c;
    __host__ __device__ void init(int M, int N, int G_, int c_) { nM = M / BM; nN = N / BM; nwg = nM * nN; G = G_; c = c_; }
    __host__ __device__ bool next(int i, Unit& u) const {
        const long L = (long)i * G + c; if (L >= nwg) return false;
        int wgid = (int)L; { const int q = nwg / NXCD, r = nwg % NXCD, xcd = wgid % NXCD, off = wgid / NXCD; wgid = (xcd < r ? xcd * (q + 1) : r * (q + 1) + (xcd - r) * q) + off; }
        const int nig = WGM * nN, gid = wgid / nig, fm = gid * WGM, gsz = (nM - fm) < WGM ? (nM - fm) : WGM;
        u.pm = fm + ((wgid % nig) % gsz); u.pn = (wgid % nig) / gsz; return true;
    }
    __device__ __forceinline__ void a_ready(const Unit&) const {}
    __device__ __forceinline__ void done(const Unit&) const {}
};
typedef float f32x2c __attribute__((ext_vector_type(2)));
typedef __bf16 bf16x2c __attribute__((ext_vector_type(2)));
__device__ __forceinline__ unsigned cvt_pk_bf16(float lo, float hi) { f32x2c v; v.x = lo; v.y = hi; bf16x2c b = __builtin_convertvector(v, bf16x2c); return __builtin_bit_cast(unsigned, b); }
template <class Epi, class Sched>
__device__ __forceinline__ void gemm_phase(PG8_LAS unsigned char* lds, const Gemm g, const Sched& S, const Epi& E) {
    int tid_ = threadIdx.x; asm volatile("" : "+v"(tid_));
    const int tid = tid_, wid = __builtin_amdgcn_readfirstlane(tid >> 6), lane = tid & 63, wr = wid >> 2, wc = wid & 3, fr = lane & 15, fq = lane >> 4;
    const int K = g.K, nt = K / BK;
    unsigned voffA[2], voffB[2];
#pragma unroll
    for (int i = 0; i < 2; ++i) { int R, C; stage_rc(tid * 16 + i * 8192, R, C); const int Rb = Epi::PERM ? ((R & ~31) + perm32(R & 31)) : R;
        voffA[i] = (unsigned)(R * g.lda + C) * 2u; voffB[i] = (unsigned)(Rb * g.ldb + C) * 2u; }
    const size_t kstep = (size_t)(BK * 2);
    const size_t hstepA = (size_t)HALF * g.lda * 2, hstepB = (size_t)HALF * g.ldb * 2;
    const size_t tstepA = 2 * hstepA, tstepB = 2 * hstepB;
    const unsigned ldsw = (unsigned)wid * 1024u;
    const int aoff = lds_byte(wr * 64 + fr, fq * 8), boff = lds_byte(wc * 32 + fr, fq * 8);
#define PG8_SA(b, h) (((b) * 2 + (h)) * HTB)
#define PG8_SB(b, h) ((4 + (b) * 2 + (h)) * HTB)
#define PG8_STAGE(bufoff, gbase, voff) do { _Pragma("unroll") for (int _i = 0; _i < 2; ++_i) \
        __builtin_amdgcn_global_load_lds((const unsigned*)((const char*)(gbase) + (voff)[_i]), (PG8_LAS unsigned*)(lds + (bufoff) + ldsw + _i * 8192), 16, 0, 0); } while (0)
#define PG8_LDA(dst, b, h) do { _Pragma("unroll") for (int m = 0; m < 4; ++m) _Pragma("unroll") for (int k = 0; k < 2; ++k) dst[m][k] = *(const PG8_LAS bf16x8*)(lds + PG8_SA(b, h) + aoff + m * 2048 + k * 1024); } while (0)
#define PG8_LDB(dst, b, h) do { _Pragma("unroll") for (int n = 0; n < 2; ++n) _Pragma("unroll") for (int k = 0; k < 2; ++k) dst[n][k] = *(const PG8_LAS bf16x8*)(lds + PG8_SB(b, h) + boff + n * 2048 + k * 1024); } while (0)
#define PG8_MMA(ai, bj, At, Bt) do { __builtin_amdgcn_s_setprio(1); _Pragma("unroll") for (int m = 0; m < 4; ++m) _Pragma("unroll") for (int n = 0; n < 2; ++n) _Pragma("unroll") for (int k = 0; k < 2; ++k) \
        acc[ai][bj][m][n] = __builtin_amdgcn_mfma_f32_16x16x32_bf16(Bt[n][k], At[m][k], acc[ai][bj][m][n], 0, 0, 0); __builtin_amdgcn_s_setprio(0); } while (0)
#define PG8_WAIT_V(n) asm volatile("s_waitcnt vmcnt(" #n ")" ::: "memory")
#define PG8_WAIT_L(n) asm volatile("s_waitcnt lgkmcnt(" #n ")" ::: "memory")
#define PG8_BAR __builtin_amdgcn_s_barrier()
#define PG8_SCHED __builtin_amdgcn_sched_barrier(0)
    Unit cur, nxt; int ui = 0;
    if (!S.next(0, cur)) return;
    f32x4 acc[2][2][4][2];
#pragma unroll
    for (int a = 0; a < 2; ++a)
#pragma unroll
        for (int b = 0; b < 2; ++b)
#pragma unroll
            for (int m = 0; m < 4; ++m)
#pragma unroll
                for (int n = 0; n < 2; ++n) acc[a][b][m][n] = (f32x4){0.f, 0.f, 0.f, 0.f};
    bf16x8 At[4][2], B0[2][2], B1[2][2];
    const char* cA = (const char*)g.A + (size_t)cur.pm * tstepA; const char* cB = (const char*)g.Bt + (size_t)cur.pn * tstepB;
    S.a_ready(cur);
    PG8_STAGE(PG8_SB(0, 0), cB, voffB); PG8_STAGE(PG8_SA(0, 0), cA, voffA); PG8_STAGE(PG8_SB(0, 1), cB + hstepB, voffB); PG8_STAGE(PG8_SA(0, 1), cA + hstepA, voffA);
    if (wr == 1) PG8_BAR;
    PG8_WAIT_V(4); PG8_BAR;
    PG8_STAGE(PG8_SB(1, 0), cB + kstep, voffB); PG8_STAGE(PG8_SA(1, 0), cA + kstep, voffA); PG8_STAGE(PG8_SB(1, 1), cB + hstepB + kstep, voffB);
    PG8_WAIT_V(6); PG8_BAR;
    for (;;) {
        const bool has_next = S.next(ui + 1, nxt);
        const char* nA = has_next ? (const char*)g.A + (size_t)nxt.pm * tstepA : cA; const char* nB = has_next ? (const char*)g.Bt + (size_t)nxt.pn * tstepB : cB;
        for (int t = 0; t < nt; t += 2) {
            const bool last = (t == nt - 2);
            const char* a1 = cA + (size_t)(t + 1) * kstep;
            const char* a2 = last ? nA : cA + (size_t)(t + 2) * kstep; const char* b2 = last ? nB : cB + (size_t)(t + 2) * kstep;
            const char* a3 = a2 + kstep; const char* b3 = b2 + kstep;
            if (last && has_next) S.a_ready(nxt);
            PG8_LDB(B0, 0, 0); PG8_SCHED; PG8_LDA(At, 0, 0); PG8_STAGE(PG8_SA(1, 1), a1 + hstepA, voffA);
            PG8_WAIT_L(8); PG8_BAR; PG8_WAIT_L(0); PG8_MMA(0, 0, At, B0); PG8_BAR; PG8_SCHED;
            PG8_LDB(B1, 0, 1); PG8_STAGE(PG8_SB(0, 0), b2, voffB);
            PG8_BAR; PG8_WAIT_L(0); PG8_MMA(0, 1, At, B1); PG8_BAR;
            PG8_LDA(At, 0, 1); PG8_STAGE(PG8_SA(0, 0), a2, voffA);
            PG8_BAR; PG8_WAIT_L(0); PG8_MMA(1, 0, At, B0); PG8_BAR; PG8_SCHED;
            PG8_STAGE(PG8_SB(0, 1), b2 + hstepB, voffB);
            PG8_WAIT_V(6); PG8_BAR; PG8_MMA(1, 1, At, B1); PG8_BAR;
            PG8_LDB(B0, 1, 0); PG8_SCHED; PG8_LDA(At, 1, 0); PG8_STAGE(PG8_SA(0, 1), a2 + hstepA, voffA);
            PG8_WAIT_L(8); PG8_BAR; PG8_WAIT_L(0); PG8_MMA(0, 0, At, B0); PG8_BAR; PG8_SCHED;
            PG8_LDB(B1, 1, 1); PG8_STAGE(PG8_SB(1, 0), b3, voffB);
            PG8_BAR; PG8_WAIT_L(0); PG8_MMA(0, 1, At, B1); PG8_BAR;
            PG8_LDA(At, 1, 1); PG8_STAGE(PG8_SA(1, 0), a3, voffA);
            PG8_BAR; PG8_WAIT_L(0); PG8_MMA(1, 0, At, B0); PG8_BAR; PG8_SCHED;
            PG8_STAGE(PG8_SB(1, 1), b3 + hstepB, voffB);
            PG8_WAIT_V(6); PG8_BAR; PG8_MMA(1, 1, At, B1); PG8_BAR;
        }
        if constexpr (!Epi::AFTER_DRAIN) { E(acc, cur, wr, wc, fr, fq); S.done(cur); }
        if (!has_next) break;
#pragma unroll
        for (int a = 0; a < 2; ++a)
#pragma unroll
            for (int b = 0; b < 2; ++b)
#pragma unroll
                for (int m = 0; m < 4; ++m)
#pragma unroll
                    for (int n = 0; n < 2; ++n) acc[a][b][m][n] = (f32x4){0.f, 0.f, 0.f, 0.f};
        cur = nxt; cA = nA; cB = nB; ++ui;
    }
    PG8_WAIT_V(0);
    if (wr == 0) PG8_BAR;
    PG8_BAR;
    if constexpr (Epi::AFTER_DRAIN) { E.fused(acc, cur, wr, wc, fr, fq, lds, wid, lane); S.done(cur); }
#undef PG8_SA
#undef PG8_SB
#undef PG8_STAGE
#undef PG8_LDA
#undef PG8_LDB
#undef PG8_MMA
#undef PG8_WAIT_V
#undef PG8_WAIT_L
#undef PG8_BAR
#undef PG8_SCHED
}
}
using pg8::bf16_t; using pg8::bf16x8; using pg8::f32x4; using pg8::u32x4; using pg8::Unit; using pg8::BM; using pg8::HALF;
typedef unsigned u32x2 __attribute__((ext_vector_type(2)));
typedef float f32x2 __attribute__((ext_vector_type(2)));

constexpr int T = 32768, SEQ = 4096, DM = 1024, DFF = 2816;
constexpr size_t MiB = 1ull << 20;
constexpr size_t OFF_WBF = 0, OFF_A = 52 * MiB, OFF_B = 116 * MiB;
constexpr size_t OFF_KRAW = 292 * MiB, OFF_KF = 324 * MiB, OFF_MLP = 510 * MiB;
constexpr size_t OFF_UTHY = 116 * MiB, OFF_URW = 388 * MiB, OFF_ZT = 212 * MiB;
constexpr size_t OFF_R = 52 * MiB, OFF_K = 84 * MiB, OFF_KK = 116 * MiB, OFF_AF = 148 * MiB, OFF_AB = 180 * MiB, OFF_LWF = 244 * MiB, OFF_LWB = 276 * MiB, OFF_G = 308 * MiB, OFF_V = 340 * MiB, OFF_BONUS = 372 * MiB;
constexpr size_t OFF_MH = 372 * MiB, OFF_MR = 436 * MiB;
constexpr size_t OFF_YF = 388 * MiB, OFF_YB = 420 * MiB, OFF_ACAT = 116 * MiB, OFF_GATES = 244 * MiB, OFF_MERGED = 372 * MiB;
constexpr size_t W_GU1 = 0, W_D1 = W_GU1 + 5632ull * 1024, W_INHY = W_D1 + 1024ull * 2816, W_INRW = W_INHY + 1536ull * 1024, W_GT = W_INRW + 2048ull * 1024,
                 W_HY = W_GT + 2048ull * 1024, W_RW = W_HY + 1024ull * 512, W_O = W_RW + 1024ull * 512, W_GU2 = W_O + 1024ull * 1024, W_D2 = W_GU2 + 5632ull * 1024,
                 W_W2T = W_D2 + 1024ull * 2816, W_A2T = W_W2T + 2ull * 512 * 64, W_G2T = W_A2T + 2ull * 512 * 64, W_END = W_G2T + 512ull * 160;
static_assert(W_END * 2 <= 52 * MiB, "wbf");
constexpr int LDS_BYTES = 147456;
constexpr size_t OFF_BAR = 511 * MiB;
constexpr size_t OFF_X3 = 292 * MiB;

struct Args { const float* in[35]; float* out; unsigned char* ws; };

__device__ __forceinline__ int TIDX() { int t = threadIdx.x; asm volatile("" : "+v"(t)); return t; }
__device__ __forceinline__ float bf2f(unsigned short b) { return __uint_as_float((unsigned)b << 16); }
__device__ __forceinline__ float bflo(unsigned w) { return __uint_as_float(w << 16); }
__device__ __forceinline__ float bfhi(unsigned w) { return __uint_as_float(w & 0xffff0000u); }
__device__ __forceinline__ unsigned pk2(float lo, float hi) { return pg8::cvt_pk_bf16(lo, hi); }
__device__ __forceinline__ bf16_t f2bf(float f) { return (bf16_t)(pk2(f, 0.f) & 0xffffu); }
__device__ __forceinline__ float sigm(float x) { return __builtin_amdgcn_rcpf(1.f + __expf(-x)); }
__device__ __forceinline__ float wave_sum(float s) { for (int o = 32; o > 0; o >>= 1) s += __shfl_xor(s, o); return s; }
template <int CTRL> __device__ __forceinline__ float dpp_f(float x) { return __int_as_float(__builtin_amdgcn_update_dpp(0, __float_as_int(x), CTRL, 0xf, 0xf, false)); }
__device__ __forceinline__ float row16_allsum(float x) { x += dpp_f<0x128>(x); x += dpp_f<0x124>(x); x += dpp_f<0x122>(x); x += dpp_f<0x121>(x); return x; }
__device__ __forceinline__ float row16_allsum_r(float x) { x += dpp_f<0x121>(x); x += dpp_f<0x122>(x); x += dpp_f<0x124>(x); x += dpp_f<0x128>(x); return x; }

struct EpiGU {
    static constexpr bool PERM = true, AFTER_DRAIN = false;
    bf16_t* O;
    __device__ __forceinline__ void operator()(const f32x4 (&acc)[2][2][4][2], const Unit& u, int wr, int wc, int fr, int fq) const {
        const int row0 = u.pm * BM + wr * 64 + fr, col0 = u.pn * 128 + wc * 32 + 8 * fq;
#pragma unroll
        for (int ai = 0; ai < 2; ++ai)
#pragma unroll
            for (int m = 0; m < 4; ++m) {
                float h[8];
#pragma unroll
                for (int n = 0; n < 2; ++n)
#pragma unroll
                    for (int j = 0; j < 4; ++j) { const float g = acc[ai][0][m][n][j], up = acc[ai][1][m][n][j]; h[n * 4 + j] = g * sigm(g) * up; }
                u32x4 w; w.x = pk2(h[0], h[1]); w.y = pk2(h[2], h[3]); w.z = pk2(h[4], h[5]); w.w = pk2(h[6], h[7]);
                *(u32x4*)(O + (size_t)(row0 + ai * HALF + m * 16) * DFF + col0) = w;
            }
    }
};
template <int BB  , int OB  > struct EpiResidT {
    static constexpr bool PERM = true, AFTER_DRAIN = false;
    const void* base; void* out; float scale;
    __device__ __forceinline__ void operator()(const f32x4 (&acc)[2][2][4][2], const Unit& u, int wr, int wc, int fr, int fq) const {
        const int row0 = u.pm * BM + wr * 64 + fr, col0 = u.pn * BM + wc * 32 + 8 * fq;
#pragma unroll
        for (int ai = 0; ai < 2; ++ai)
#pragma unroll
            for (int m = 0; m < 4; ++m) { const size_t off = (size_t)(row0 + ai * HALF + m * 16) * DM + col0;
#pragma unroll
                for (int bj = 0; bj < 2; ++bj) { const size_t o2 = off + bj * HALF; f32x4 b0, b1;
                    if (BB) { const u32x4 t = *(const u32x4*)((const bf16_t*)base + o2); b0[0] = bflo(t.x); b0[1] = bfhi(t.x); b0[2] = bflo(t.y); b0[3] = bfhi(t.y); b1[0] = bflo(t.z); b1[1] = bfhi(t.z); b1[2] = bflo(t.w); b1[3] = bfhi(t.w); }
                    else { b0 = *(const f32x4*)((const float*)base + o2); b1 = *(const f32x4*)((const float*)base + o2 + 4); }
                    const f32x4 x0 = b0 + acc[ai][bj][m][0] * scale, x1 = b1 + acc[ai][bj][m][1] * scale;
                    if (OB) { u32x4 w; w.x = pk2(x0[0], x0[1]); w.y = pk2(x0[2], x0[3]); w.z = pk2(x1[0], x1[1]); w.w = pk2(x1[2], x1[3]); *(u32x4*)((bf16_t*)out + o2) = w; }
                    else { *(f32x4*)((float*)out + o2) = x0; *(f32x4*)((float*)out + o2 + 4) = x1; } } }
    }
};
template <int ACT> struct EpiBf16 {
    static constexpr bool PERM = true, AFTER_DRAIN = false;
    bf16_t* O; int ldc; int ncols;
    __device__ __forceinline__ void operator()(const f32x4 (&acc)[2][2][4][2], const Unit& u, int wr, int wc, int fr, int fq) const {
        const int row0 = u.pm * BM + wr * 64 + fr, col0 = u.pn * BM + wc * 32 + 8 * fq;
#pragma unroll
        for (int ai = 0; ai < 2; ++ai)
#pragma unroll
            for (int m = 0; m < 4; ++m)
#pragma unroll
                for (int bj = 0; bj < 2; ++bj) { const int col = col0 + bj * HALF; f32x4 v0 = acc[ai][bj][m][0], v1 = acc[ai][bj][m][1];
                    if (ACT == 1) {
#pragma unroll
                        for (int j = 0; j < 4; ++j) { v0[j] = sigm(v0[j]); v1[j] = sigm(v1[j]); } }
                    u32x4 w; w.x = pk2(v0[0], v0[1]); w.y = pk2(v0[2], v0[3]); w.z = pk2(v1[0], v1[1]); w.w = pk2(v1[2], v1[3]);
                    if (col < ncols) *(u32x4*)(O + (size_t)(row0 + ai * HALF + m * 16) * ldc + col) = w; }
    }
};
template <int SECOND> struct EpiMerge {
    static constexpr bool PERM = true, AFTER_DRAIN = false;
    bf16_t* Mg; const bf16_t* gates; int goff;
    __device__ __forceinline__ void operator()(const f32x4 (&acc)[2][2][4][2], const Unit& u, int wr, int wc, int fr, int fq) const {
        const int row0 = u.pm * BM + wr * 64 + fr, col0 = u.pn * BM + wc * 32 + 8 * fq;
#pragma unroll
        for (int ai = 0; ai < 2; ++ai)
#pragma unroll
            for (int m = 0; m < 4; ++m)
#pragma unroll
                for (int bj = 0; bj < 2; ++bj) { const int col = col0 + bj * HALF; const size_t row = (size_t)(row0 + ai * HALF + m * 16);
                    const u32x4 gt = *(const u32x4*)(gates + row * 2048 + goff + col);
                    float o[8]; const f32x4 v0 = acc[ai][bj][m][0], v1 = acc[ai][bj][m][1];
#ifdef EXP5
                    o[0] = bflo(gt.x); o[1] = bfhi(gt.x); o[2] = bflo(gt.y); o[3] = bfhi(gt.y); o[4] = bflo(gt.z); o[5] = bfhi(gt.z); o[6] = bflo(gt.w); o[7] = bfhi(gt.w);
#else
                    o[0] = bflo(gt.x) * v0[0]; o[1] = bfhi(gt.x) * v0[1]; o[2] = bflo(gt.y) * v0[2]; o[3] = bfhi(gt.y) * v0[3];
                    o[4] = bflo(gt.z) * v1[0]; o[5] = bfhi(gt.z) * v1[1]; o[6] = bflo(gt.w) * v1[2]; o[7] = bfhi(gt.w) * v1[3];
#endif
                    if (SECOND) { const u32x4 pm = *(const u32x4*)(Mg + row * DM + col);
                        o[0] += bflo(pm.x); o[1] += bfhi(pm.x); o[2] += bflo(pm.y); o[3] += bfhi(pm.y); o[4] += bflo(pm.z); o[5] += bfhi(pm.z); o[6] += bflo(pm.w); o[7] += bfhi(pm.w); }
                    u32x4 w; w.x = pk2(o[0], o[1]); w.y = pk2(o[2], o[3]); w.z = pk2(o[4], o[5]); w.w = pk2(o[6], o[7]);
                    *(u32x4*)(Mg + row * DM + col) = w; }
    }
};
template <class Epi> __device__ __forceinline__ void run_gemm(LAS unsigned char* lds, const bf16_t* A, int lda, const bf16_t* Bt, int ldb, int M, int N, int K, const Epi& E) {
    pg8::Gemm g; g.A = A; g.Bt = Bt; g.M = M; g.N = N; g.K = K; g.lda = lda; g.ldb = ldb;
    pg8::StaticOrder S; S.init(M, N, gridDim.x, blockIdx.x);
#ifndef NO_GEMM
    pg8::gemm_phase(lds, g, S, E);
#endif
}

__device__ __forceinline__ void norm_rows_bf16(const float* __restrict__ X, const float* __restrict__ g, bf16_t* __restrict__ H) {
    const int lane = TIDX() & 63, wid = TIDX() >> 6;
#pragma unroll 4
    for (int row = blockIdx.x * 8 + wid; row < T; row += gridDim.x * 8) {
        const float4* p = (const float4*)(X + (size_t)row * DM);
        float4 v[4]; float s = 0.f;
#pragma unroll
        for (int j = 0; j < 4; ++j) { v[j] = p[lane + 64 * j]; s += v[j].x * v[j].x + v[j].y * v[j].y + v[j].z * v[j].z + v[j].w * v[j].w; }
        s = wave_sum(s);
        const float r = rsqrtf(s * (1.f / DM) + 1e-6f);
#pragma unroll
        for (int j = 0; j < 4; ++j) { const float4 gg = ((const float4*)g)[lane + 64 * j]; u32x2 o; o.x = pk2(v[j].x * r * gg.x, v[j].y * r * gg.y); o.y = pk2(v[j].z * r * gg.z, v[j].w * r * gg.w);
            *(u32x2*)(H + (size_t)row * DM + (lane + 64 * j) * 4) = o; }
    }
}
__device__ __forceinline__ void norm_rows_bf16in(const bf16_t* __restrict__ X, const float* __restrict__ g, bf16_t* __restrict__ H) {
    const int lane = TIDX() & 63, wid = TIDX() >> 6;
#pragma unroll 4
    for (int row = blockIdx.x * 8 + wid; row < T; row += gridDim.x * 8) {
        const u32x4* p = (const u32x4*)(X + (size_t)row * DM);
        float v[16]; float s = 0.f;
#pragma unroll
        for (int j = 0; j < 2; ++j) { const u32x4 t = p[lane + 64 * j];
            v[8 * j + 0] = bflo(t.x); v[8 * j + 1] = bfhi(t.x); v[8 * j + 2] = bflo(t.y); v[8 * j + 3] = bfhi(t.y); v[8 * j + 4] = bflo(t.z); v[8 * j + 5] = bfhi(t.z); v[8 * j + 6] = bflo(t.w); v[8 * j + 7] = bfhi(t.w); }
#pragma unroll
        for (int i = 0; i < 16; ++i) s += v[i] * v[i];
        s = wave_sum(s);
        const float r = rsqrtf(s * (1.f / DM) + 1e-6f);
#pragma unroll
        for (int j = 0; j < 2; ++j) { const int c0 = (lane + 64 * j) * 8; const float4 ga = *(const float4*)(g + c0), gb = *(const float4*)(g + c0 + 4);
            u32x4 o; o.x = pk2(v[8 * j] * r * ga.x, v[8 * j + 1] * r * ga.y); o.y = pk2(v[8 * j + 2] * r * ga.z, v[8 * j + 3] * r * ga.w);
            o.z = pk2(v[8 * j + 4] * r * gb.x, v[8 * j + 5] * r * gb.y); o.w = pk2(v[8 * j + 6] * r * gb.z, v[8 * j + 7] * r * gb.w);
            *(u32x4*)(H + (size_t)row * DM + c0) = o; }
    }
}
__device__ __forceinline__ void norm_rows_bf16_to_f32(const bf16_t* __restrict__ X, const float* __restrict__ g, float* __restrict__ O) {
    const int lane = TIDX() & 63, wid = TIDX() >> 6;
#pragma unroll 4
    for (int row = blockIdx.x * 8 + wid; row < T; row += gridDim.x * 8) {
        const u32x4* p = (const u32x4*)(X + (size_t)row * DM);
        float v[16]; float s = 0.f;
#pragma unroll
        for (int j = 0; j < 2; ++j) { const u32x4 t = p[lane + 64 * j];
            v[8 * j + 0] = bflo(t.x); v[8 * j + 1] = bfhi(t.x); v[8 * j + 2] = bflo(t.y); v[8 * j + 3] = bfhi(t.y); v[8 * j + 4] = bflo(t.z); v[8 * j + 5] = bfhi(t.z); v[8 * j + 6] = bflo(t.w); v[8 * j + 7] = bfhi(t.w); }
#pragma unroll
        for (int i = 0; i < 16; ++i) s += v[i] * v[i];
        s = wave_sum(s);
        const float r = rsqrtf(s * (1.f / DM) + 1e-6f);
#pragma unroll
        for (int j = 0; j < 2; ++j) { const int c0 = (lane + 64 * j) * 8; const float4 ga = *(const float4*)(g + c0), gb = *(const float4*)(g + c0 + 4);
            float4 o0, o1; o0.x = v[8 * j] * r * ga.x; o0.y = v[8 * j + 1] * r * ga.y; o0.z = v[8 * j + 2] * r * ga.z; o0.w = v[8 * j + 3] * r * ga.w;
            o1.x = v[8 * j + 4] * r * gb.x; o1.y = v[8 * j + 5] * r * gb.y; o1.z = v[8 * j + 6] * r * gb.z; o1.w = v[8 * j + 7] * r * gb.w;
            *(float4*)(O + (size_t)row * DM + c0) = o0; *(float4*)(O + (size_t)row * DM + c0 + 4) = o1; }
    }
}
__device__ __forceinline__ void norm_rows_f32_out(const float* X, const float* g, float* O) {
    const int lane = TIDX() & 63, wid = TIDX() >> 6;
    for (int row = blockIdx.x * 8 + wid; row < T; row += gridDim.x * 8) {
        const float4* p = (const float4*)(X + (size_t)row * DM); float4* q = (float4*)(O + (size_t)row * DM);
        float4 v[4]; float s = 0.f;
#pragma unroll
        for (int j = 0; j < 4; ++j) { v[j] = p[lane + 64 * j]; s += v[j].x * v[j].x + v[j].y * v[j].y + v[j].z * v[j].z + v[j].w * v[j].w; }
        s = wave_sum(s);
        const float r = rsqrtf(s * (1.f / DM) + 1e-6f);
#pragma unroll
        for (int j = 0; j < 4; ++j) { const float4 gg = ((const float4*)g)[lane + 64 * j]; float4 o; o.x = v[j].x * r * gg.x; o.y = v[j].y * r * gg.y; o.z = v[j].z * r * gg.z; o.w = v[j].w * r * gg.w; q[lane + 64 * j] = o; }
    }
}
__device__ __forceinline__ void norm_rows_f32_inplace(float* X, const float* g) {
    const int lane = TIDX() & 63, wid = TIDX() >> 6;
    for (int row = blockIdx.x * 8 + wid; row < T; row += gridDim.x * 8) {
        float4* p = (float4*)(X + (size_t)row * DM);
        float4 v[4]; float s = 0.f;
#pragma unroll
        for (int j = 0; j < 4; ++j) { v[j] = p[lane + 64 * j]; s += v[j].x * v[j].x + v[j].y * v[j].y + v[j].z * v[j].z + v[j].w * v[j].w; }
        s = wave_sum(s);
        const float r = rsqrtf(s * (1.f / DM) + 1e-6f);
#pragma unroll
        for (int j = 0; j < 4; ++j) { const float4 gg = ((const float4*)g)[lane + 64 * j]; float4 o; o.x = v[j].x * r * gg.x; o.y = v[j].y * r * gg.y; o.z = v[j].z * r * gg.z; o.w = v[j].w * r * gg.w; p[lane + 64 * j] = o; }
    }
}
template <class FN> __device__ __forceinline__ void cvt_wT(const float* __restrict__ src, int ldsrc, bf16_t* __restrict__ dst, int N, int K, FN srccol) {
    const size_t total = (size_t)N * (K >> 3), gstride = (size_t)gridDim.x * 512;
    for (size_t it = (size_t)blockIdx.x * 512 + TIDX(); it < total; it += gstride) {
        const int n = (int)(it % N), k8 = (int)(it / N); const int sc = srccol(n);
        float f[8];
#pragma unroll
        for (int i = 0; i < 8; ++i) f[i] = sc >= 0 ? src[(size_t)(k8 * 8 + i) * ldsrc + sc] : 0.f;
        u32x4 o; o.x = pk2(f[0], f[1]); o.y = pk2(f[2], f[3]); o.z = pk2(f[4], f[5]); o.w = pk2(f[6], f[7]);
        *(u32x4*)(dst + (size_t)n * K + k8 * 8) = o;
    }
}
template <class FN> __device__ __forceinline__ void cvt_wT_tiled(LAS unsigned char* lds, const float* __restrict__ src, int ldsrc, bf16_t* __restrict__ dst, int N, int K, FN srccol) {
    LAS float* tile = (LAS float*)lds;
    const int tid = TIDX(), nK = K >> 6, ntiles = (N >> 6) * nK;
    for (int it = blockIdx.x; it < ntiles; it += gridDim.x) {
        const int n0 = (it / nK) << 6, k0 = (it % nK) << 6;
        __syncthreads();
        { const int n = tid & 63, kq = tid >> 6; const int sc = srccol(n0 + n);
#pragma unroll
          for (int i = 0; i < 8; ++i) { const int k = kq + 8 * i; tile[k * 65 + n] = sc >= 0 ? src[(size_t)(k0 + k) * ldsrc + sc] : 0.f; } }
        __syncthreads();
        { const int n = tid >> 3, k8 = tid & 7; float f[8];
#pragma unroll
          for (int i = 0; i < 8; ++i) f[i] = tile[(k8 * 8 + i) * 65 + n];
          u32x4 o; o.x = pk2(f[0], f[1]); o.y = pk2(f[2], f[3]); o.z = pk2(f[4], f[5]); o.w = pk2(f[6], f[7]);
          *(u32x4*)(dst + (size_t)(n0 + n) * K + k0 + k8 * 8) = o; }
    }
}
__device__ __forceinline__ int gu_col(int n) { const int pn = n >> 8, w = n & 255; return w < 128 ? pn * 128 + w : DFF + pn * 128 + (w - 128); }

__device__ __forceinline__ void merge_phase(const bf16_t* gates, const bf16_t* MH, const bf16_t* MR, bf16_t* merged) {
    const size_t n8 = (size_t)T * DM / 8;
    for (size_t i = (size_t)blockIdx.x * 512 + TIDX(); i < n8; i += (size_t)gridDim.x * 512) {
        const size_t row = i >> 7, c8 = (i & 127) * 8;
#ifdef EXP9
        const u32x4 gh = {0x3f003f00u, 0x3f003f00u, 0x3f003f00u, 0x3f003f00u}, gr = gh;
#else
        const u32x4 gh = *(const u32x4*)(gates + row * 2048 + c8), gr = *(const u32x4*)(gates + row * 2048 + 1024 + c8);
#endif
        const u32x4 mh = *(const u32x4*)(MH + i * 8), mr = *(const u32x4*)(MR + i * 8);
        u32x4 w;
        w.x = pk2(bflo(gh.x) * bflo(mh.x) + bflo(gr.x) * bflo(mr.x), bfhi(gh.x) * bfhi(mh.x) + bfhi(gr.x) * bfhi(mr.x));
        w.y = pk2(bflo(gh.y) * bflo(mh.y) + bflo(gr.y) * bflo(mr.y), bfhi(gh.y) * bfhi(mh.y) + bfhi(gr.y) * bfhi(mr.y));
        w.z = pk2(bflo(gh.z) * bflo(mh.z) + bflo(gr.z) * bflo(mr.z), bfhi(gh.z) * bfhi(mh.z) + bfhi(gr.z) * bfhi(mr.z));
        w.w = pk2(bflo(gh.w) * bflo(mh.w) + bflo(gr.w) * bflo(mr.w), bfhi(gh.w) * bfhi(mh.w) + bfhi(gr.w) * bfhi(mr.w));
        *(u32x4*)(merged + i * 8) = w;
    }
}
__device__ __forceinline__ void hy_mlp_phase(LAS unsigned char* lds, const float* w1, const float* b1, const float* w2, const float* b2, const float* fr, float* mlp) {
    const int lane = TIDX() & 63, wid = TIDX() >> 6;
    LAS float* sh = (LAS float*)lds;
    for (int pb = blockIdx.x; pb < 512; pb += gridDim.x) {
        const int p = pb * 8 + wid, j = lane;
        const float tt = (float)p / 4095.f, ang = (float)(2.0 * 3.14159265358979323846 / 4096.0) * (float)p;
        float a1 = b1[j] + tt * w1[j];
        for (int i = 0; i < 16; ++i) { const float band = 1e-4f + (float)i * ((15.f - 1e-4f) / 15.f); float sn, cs; sincosf(band * ang, &sn, &cs); a1 += cs * w1[(1 + i) * 64 + j] - sn * w1[(17 + i) * 64 + j]; }
        const float f = fr[j];
        sh[wid * 64 + j] = sinf(f * a1);
        __syncthreads();
        float a2 = b2[j];
        for (int m = 0; m < 64; ++m) a2 += sh[wid * 64 + m] * w2[m * 64 + j];
        mlp[p * 64 + j] = sinf(f * a2);
        __syncthreads();
    }
}
__device__ __forceinline__ void hy_kraw_phase(LAS unsigned char* lds, const float* w3, const float* b3, const float* decay, const float* mlp, float* kraw) {
    const int tid = TIDX(), lane = tid & 63, wid = tid >> 6;
    LAS float* w3s = (LAS float*)lds;
    for (int item = blockIdx.x; item < 256; item += gridDim.x) {
        const int ob = item >> 3, pg = item & 7;
        __syncthreads();
        for (int e = tid; e < 4096; e += 512) w3s[e] = w3[(size_t)(e >> 6) * 2048 + ob * 64 + (e & 63)];
        __syncthreads();
        const int p = (pg * 8 + wid) * 64 + lane;
        float h[64];
#pragma unroll
        for (int q = 0; q < 16; ++q) { const float4 t4 = *(const float4*)(mlp + (size_t)p * 64 + q * 4); h[q * 4] = t4.x; h[q * 4 + 1] = t4.y; h[q * 4 + 2] = t4.z; h[q * 4 + 3] = t4.w; }
        const float tt = (float)p / 4095.f;
        for (int o4 = 0; o4 < 16; ++o4) {
            const int og0 = ob * 64 + o4 * 4;
            float4 acc = *(const float4*)(b3 + og0);
#pragma unroll
            for (int m = 0; m < 64; ++m) { const f32x4 w = *(const LAS f32x4*)(w3s + m * 64 + o4 * 4); acc.x += h[m] * w.x; acc.y += h[m] * w.y; acc.z += h[m] * w.z; acc.w += h[m] * w.w; }
            const float av[4] = {acc.x, acc.y, acc.z, acc.w};
#pragma unroll
            for (int q = 0; q < 4; ++q) { const int og = og0 + q, dir = og >> 10; const float dec = fabsf(decay[og]);
                float val = av[q] * __expf(-tt * dec);
                int j = p; if (dir) { j = (p == 0) ? 4096 : 8192 - p; if (p == 0) val = 0.f; }
                kraw[(size_t)(og & 1023) * 8192 + j] = val; }
        }
    }
}
#define FPAD(i) ((i) + ((i) >> 3))
constexpr int FFT_X_BYTES = (8192 + 1024) * 8, FFT_TW_OFF = FFT_X_BYTES, FFT_RED_OFF = FFT_TW_OFF + 4096 * 8;
__device__ __forceinline__ f32x2 mk2(float a, float b) { f32x2 r; r.x = a; r.y = b; return r; }
__device__ __forceinline__ f32x2 cmul(f32x2 a, f32x2 b) { return mk2(a.x * b.x - a.y * b.y, a.x * b.y + a.y * b.x); }
__device__ __forceinline__ f32x2 cmulc(f32x2 a, f32x2 b) { return mk2(a.x * b.x + a.y * b.y, a.y * b.x - a.x * b.y); }
__device__ __forceinline__ f32x2 cexp16(int q) {
    constexpr float CT[9] = {1.f, 0.98078528040f, 0.92387953251f, 0.83146961230f, 0.70710678119f, 0.55557023302f, 0.38268343236f, 0.19509032202f, 0.f};
    const float c = q <= 8 ? CT[q] : -CT[16 - q]; const float s = q <= 8 ? CT[8 - q] : CT[q - 8]; return mk2(c, -s);
}
template <int S, int HSL, bool INV> __device__ __forceinline__ void fft_pass(LAS f32x2* X, const LAS f32x2* tw) {
    constexpr int R = 1 << S, hs = 1 << HSL;
    for (int g = TIDX(); g < (8192 >> S); g += 512) {
        const int lo = g & (hs - 1), i0 = ((g >> HSL) << (HSL + S)) + lo;
        f32x2 v[R];
#pragma unroll
        for (int m = 0; m < R; ++m) v[m] = X[FPAD(i0 + m * hs)];
        f32x2 B[S];
        B[0] = (HSL == 0) ? mk2(1.f, 0.f) : tw[lo << (12 - HSL - (S - 1))];
#pragma unroll
        for (int s = 1; s < S; ++s) B[s] = cmul(B[s - 1], B[s - 1]);
#pragma unroll
        for (int ss = 0; ss < S; ++ss) {
            const int s = INV ? (S - 1 - ss) : ss; const int ms = 1 << (S - 1 - s);
#pragma unroll
            for (int m = 0; m < R; ++m) if (!(m & ms)) {
                const int q = (m & (ms - 1)) * (16 / ms);
                const f32x2 w = (HSL == 0) ? cexp16(q) : (q == 0 ? B[s] : cmul(B[s], cexp16(q)));
                if (!INV) { const f32x2 a = v[m], b = v[m + ms]; v[m] = a + b; v[m + ms] = cmul(a - b, w); }
                else { const f32x2 a = v[m], b = cmulc(v[m + ms], w); v[m] = a + b; v[m + ms] = a - b; }
            }
        }
#pragma unroll
        for (int m = 0; m < R; ++m) X[FPAD(i0 + m * hs)] = v[m];
    }
    __syncthreads();
}
__device__ __forceinline__ void fft_mid(LAS f32x2* X, const f32x2* kf) {
    for (int g = TIDX(); g < 1024; g += 512) {
        const int i0 = g * 8;
        f32x2 v[8];
#pragma unroll
        for (int m = 0; m < 8; ++m) v[m] = X[FPAD(i0 + m)];
#pragma unroll
        for (int s = 0; s < 3; ++s) { const int ms = 4 >> s;
#pragma unroll
            for (int m = 0; m < 8; ++m) if (!(m & ms)) { const f32x2 w = cexp16((m & (ms - 1)) * (16 / ms)); const f32x2 a = v[m], b = v[m + ms]; v[m] = a + b; v[m + ms] = cmul(a - b, w); } }
#pragma unroll
        for (int m = 0; m < 8; ++m) v[m] = cmul(v[m], kf[i0 + m]);
#pragma unroll
        for (int s = 2; s >= 0; --s) { const int ms = 4 >> s;
#pragma unroll
            for (int m = 0; m < 8; ++m) if (!(m & ms)) { const f32x2 w = cexp16((m & (ms - 1)) * (16 / ms)); const f32x2 a = v[m], b = cmulc(v[m + ms], w); v[m] = a + b; v[m + ms] = a - b; } }
#pragma unroll
        for (int m = 0; m < 8; ++m) X[FPAD(i0 + m)] = v[m];
    }
    __syncthreads();
}
__device__ __forceinline__ void fft_fwd3(LAS f32x2* X, const LAS f32x2* tw) { fft_pass<4, 9, false>(X, tw); fft_pass<3, 6, false>(X, tw); fft_pass<3, 3, false>(X, tw); }
__device__ __forceinline__ void fft_fwd(LAS f32x2* X, const LAS f32x2* tw) { fft_fwd3(X, tw); fft_pass<3, 0, false>(X, tw); }
__device__ __forceinline__ void fft_inv3(LAS f32x2* X, const LAS f32x2* tw) { fft_pass<3, 3, true>(X, tw); fft_pass<3, 6, true>(X, tw); fft_pass<4, 9, true>(X, tw); }
__device__ __forceinline__ void build_tw(LAS f32x2* tw) { for (int e = TIDX(); e < 4096; e += 512) { float s, c; sincospif(-(float)e / 4096.f, &s, &c); tw[e] = mk2(c, s); } __syncthreads(); }

__device__ __forceinline__ void hy_filter_fft_phase(LAS unsigned char* lds, const float* kraw, f32x2* Kf) {
    const int tid = TIDX(), lane = tid & 63, wid = tid >> 6;
    LAS f32x2* X = (LAS f32x2*)lds; LAS f32x2* tw = (LAS f32x2*)(lds + FFT_TW_OFF); LAS float* red = (LAS float*)(lds + FFT_RED_OFF);
    build_tw(tw);
    for (int f = blockIdx.x; f < 1024; f += gridDim.x) {
        float ss = 0.f;
#pragma unroll
        for (int k = 0; k < 4; ++k) { const int i = 4 * tid + 2048 * k; const float4 v = *(const float4*)(kraw + (size_t)f * 8192 + i);
            ss += v.x * v.x + v.y * v.y + v.z * v.z + v.w * v.w; X[FPAD(i)] = mk2(v.x, 0.f); X[FPAD(i + 1)] = mk2(v.y, 0.f); X[FPAD(i + 2)] = mk2(v.z, 0.f); X[FPAD(i + 3)] = mk2(v.w, 0.f); }
        ss = wave_sum(ss); if (lane == 0) red[wid] = ss;
        __syncthreads();
        float tot = 0.f;
#pragma unroll
        for (int w = 0; w < 8; ++w) tot += red[w];
        fft_fwd(X, tw);
        const float sc = rsqrtf(tot + 1e-6f) * (1.f / 8192.f);
#pragma unroll
        for (int k = 0; k < 8; ++k) { const int i = 2 * tid + 1024 * k; const f32x2 a = X[FPAD(i)], b = X[FPAD(i + 1)]; f32x4 o; o.x = a.x * sc; o.y = a.y * sc; o.z = b.x * sc; o.w = b.y * sc; *(f32x4*)(Kf + (size_t)f * 8192 + i) = o; }
        __syncthreads();
    }
}
__device__ __forceinline__ float conv3at(const bf16_t* row, int t, float w0, float w1, float w2, float bb) {
    const float um = t > 0 ? bf2f(row[t - 1]) : 0.f, u0 = bf2f(row[t]), up = t < SEQ - 1 ? bf2f(row[t + 1]) : 0.f;
    return w0 * um + w1 * u0 + w2 * up + bb;
}
__device__ __forceinline__ void hyena_trivial(const bf16_t* uT, bf16_t* zT) {
    for (size_t i = (size_t)blockIdx.x * 512 + TIDX(); i < (size_t)512 * T; i += (size_t)gridDim.x * 512) {
        zT[i] = f2bf(bf2f(uT[i]) * bf2f(uT[i + (size_t)512 * T]) * bf2f(uT[i + (size_t)1024 * T])); }
}
__device__ __forceinline__ void conv8(const bf16_t* row, int t0, float w0, float w1, float w2, float bb, float (&o)[8]) {
    const u32x4 u = *(const u32x4*)(row + t0);
    const float pv = t0 > 0 ? bf2f(row[t0 - 1]) : 0.f, nx = (t0 + 8 < SEQ) ? bf2f(row[t0 + 8]) : 0.f;
    const float x[10] = {pv, bflo(u.x), bfhi(u.x), bflo(u.y), bfhi(u.y), bflo(u.z), bfhi(u.z), bflo(u.w), bfhi(u.w), nx};
#pragma unroll
    for (int m = 0; m < 8; ++m) o[m] = w0 * x[m] + w1 * x[m + 1] + w2 * x[m + 2] + bb;
}
__device__ __forceinline__ void hyena_phase(LAS unsigned char* lds, const bf16_t* uT, const f32x2* Kf, const float* cw, const float* cb, const float* bias_d, bf16_t* zT) {
    const int tid = TIDX();
    LAS f32x2* X = (LAS f32x2*)lds; LAS f32x2* tw = (LAS f32x2*)(lds + FFT_TW_OFF);
    build_tw(tw);
    const int t0 = tid * 8;
    for (int item = blockIdx.x * 4; item < 2048; item = ((item & 3) == 3) ? (item - 3 + 4 * (int)gridDim.x) : (item + 1)) {
        const int c = item >> 2, pr = item & 3;
        const size_t bo0 = (size_t)(pr * 2) * SEQ, bo1 = bo0 + SEQ;
        const bf16_t* r1 = uT + (size_t)c * T; const bf16_t* r2 = uT + (size_t)(512 + c) * T; const bf16_t* r3 = uT + (size_t)(1024 + c) * T;
        const float a0 = cw[c], a1 = cw[1536 + c], a2 = cw[3072 + c], ab = cb[c];
        const float b0 = cw[512 + c], b1 = cw[1536 + 512 + c], b2 = cw[3072 + 512 + c], bb = cb[512 + c];
        const float v0 = cw[1024 + c], v1 = cw[1536 + 1024 + c], v2 = cw[3072 + 1024 + c], vb = cb[1024 + c];
        const float d0 = bias_d[c], d1 = bias_d[512 + c];
        float va[8], vbt[8];
        conv8(r3 + bo0, t0, v0, v1, v2, vb, va); conv8(r3 + bo1, t0, v0, v1, v2, vb, vbt);
#pragma unroll
        for (int m = 0; m < 8; ++m) { X[FPAD(t0 + m)] = mk2(va[m], vbt[m]); X[FPAD(4096 + t0 + m)] = mk2(0.f, 0.f); }
        __syncthreads();
        fft_fwd3(X, tw); fft_mid(X, Kf + (size_t)c * 8192); fft_inv3(X, tw);
        f32x2 z2[8];
        { float xa[8], xb[8];
          conv8(r1 + bo0, t0, a0, a1, a2, ab, xa); conv8(r1 + bo1, t0, a0, a1, a2, ab, xb);
#pragma unroll
          for (int m = 0; m < 8; ++m) { const f32x2 y = X[FPAD(t0 + m)]; z2[m] = mk2(xa[m] * (y.x + d0 * va[m]), xb[m] * (y.y + d0 * vbt[m])); } }
        __syncthreads();
#pragma unroll
        for (int m = 0; m < 8; ++m) { X[FPAD(t0 + m)] = z2[m]; X[FPAD(4096 + t0 + m)] = mk2(0.f, 0.f); }
        __syncthreads();
        fft_fwd3(X, tw); fft_mid(X, Kf + (size_t)(512 + c) * 8192); fft_inv3(X, tw);
        { float xa[8], xb[8]; float oa[8], ob[8];
          conv8(r2 + bo0, t0, b0, b1, b2, bb, xa); conv8(r2 + bo1, t0, b0, b1, b2, bb, xb);
#pragma unroll
          for (int m = 0; m < 8; ++m) { const f32x2 y = X[FPAD(t0 + m)]; oa[m] = xa[m] * (y.x + d1 * z2[m].x); ob[m] = xb[m] * (y.y + d1 * z2[m].y); }
          u32x4 w; w.x = pk2(oa[0], oa[1]); w.y = pk2(oa[2], oa[3]); w.z = pk2(oa[4], oa[5]); w.w = pk2(oa[6], oa[7]);
          *(u32x4*)(zT + (size_t)c * T + bo0 + t0) = w;
          w.x = pk2(ob[0], ob[1]); w.y = pk2(ob[2], ob[3]); w.z = pk2(ob[4], ob[5]); w.w = pk2(ob[6], ob[7]);
          *(u32x4*)(zT + (size_t)c * T + bo1 + t0) = w; }
        __syncthreads();
    }
}
struct RwP { const bf16_t* urw; const float* mu; const float* w0; const float* a0; const float* k_k; const float* k_a; const float* r_k;
             const bf16_t* w2t; const bf16_t* a2t; const bf16_t* g2t;
             bf16_t *r, *k, *v, *kk, *af, *ab, *lwf, *lwb, *g; float* bonus; };
__device__ __forceinline__ float4 shiftq(const bf16_t* urw, int t, int tl, int sc, const float* mu) {
    const u32x2 u = *(const u32x2*)(urw + (size_t)t * 1952 + sc);
    u32x2 p = {0u, 0u}, n = {0u, 0u};
    if (tl > 0) p = *(const u32x2*)(urw + (size_t)(t - 1) * 1952 + sc);
    if (tl < SEQ - 1) n = *(const u32x2*)(urw + (size_t)(t + 1) * 1952 + sc);
    const float4 m0 = *(const float4*)(mu + sc), m1 = *(const float4*)(mu + 1952 + sc);
    float4 o; float uu, pp, nn;
    uu = bflo(u.x); pp = bflo(p.x); nn = bflo(n.x); o.x = uu + m0.x * (pp - uu) + m1.x * (nn - uu);
    uu = bfhi(u.x); pp = bfhi(p.x); nn = bfhi(n.x); o.y = uu + m0.y * (pp - uu) + m1.y * (nn - uu);
    uu = bflo(u.y); pp = bflo(p.y); nn = bflo(n.y); o.z = uu + m0.z * (pp - uu) + m1.z * (nn - uu);
    uu = bfhi(u.y); pp = bfhi(p.y); nn = bfhi(n.y); o.w = uu + m0.w * (pp - uu) + m1.w * (nn - uu);
    return o;
}
__device__ __forceinline__ void shift8(const bf16_t* urw, int t, int tl, int sc, const float* mu, float (&o)[8]) {
    const u32x4 u = *(const u32x4*)(urw + (size_t)t * 1952 + sc);
    u32x4 p = {0u, 0u, 0u, 0u}, n = p;
    if (tl > 0) p = *(const u32x4*)(urw + (size_t)(t - 1) * 1952 + sc);
    if (tl < SEQ - 1) n = *(const u32x4*)(urw + (size_t)(t + 1) * 1952 + sc);
    const float4 m0a = *(const float4*)(mu + sc), m0b = *(const float4*)(mu + sc + 4), m1a = *(const float4*)(mu + 1952 + sc), m1b = *(const float4*)(mu + 1952 + sc + 4);
    const float u8[8] = {bflo(u.x), bfhi(u.x), bflo(u.y), bfhi(u.y), bflo(u.z), bfhi(u.z), bflo(u.w), bfhi(u.w)};
    const float p8[8] = {bflo(p.x), bfhi(p.x), bflo(p.y), bfhi(p.y), bflo(p.z), bfhi(p.z), bflo(p.w), bfhi(p.w)};
    const float n8[8] = {bflo(n.x), bfhi(n.x), bflo(n.y), bfhi(n.y), bflo(n.z), bfhi(n.z), bflo(n.w), bfhi(n.w)};
    const float m0[8] = {m0a.x, m0a.y, m0a.z, m0a.w, m0b.x, m0b.y, m0b.z, m0b.w}, m1[8] = {m1a.x, m1a.y, m1a.z, m1a.w, m1b.x, m1b.y, m1b.z, m1b.w};
#pragma unroll
    for (int i = 0; i < 8; ++i) o[i] = u8[i] + m0[i] * (p8[i] - u8[i]) + m1[i] * (n8[i] - u8[i]);
}
__device__ __forceinline__ void ld8f(const float* p, float (&o)[8]) { const float4 a = *(const float4*)p, b = *(const float4*)(p + 4); o[0] = a.x; o[1] = a.y; o[2] = a.z; o[3] = a.w; o[4] = b.x; o[5] = b.y; o[6] = b.z; o[7] = b.w; }
__device__ __forceinline__ void st8bf(bf16_t* p, const float (&v)[8]) { u32x4 o; o.x = pk2(v[0], v[1]); o.y = pk2(v[2], v[3]); o.z = pk2(v[4], v[5]); o.w = pk2(v[6], v[7]); *(u32x4*)p = o; }
__device__ __forceinline__ void st4bf(bf16_t* p, float a, float b, float c, float d) { u32x2 o; o.x = pk2(a, b); o.y = pk2(c, d); *(u32x2*)p = o; }
__device__ __forceinline__ void rwprep_phase(LAS unsigned char* lds, const RwP P) {
    const int tid = TIDX(), lane = tid & 63, hw = tid >> 6, fr = lane & 15, fq = lane >> 4;
    LAS bf16_t* At = (LAS bf16_t*)lds;
    for (int tt = blockIdx.x; tt < T / 16; tt += gridDim.x) {
        const int t0 = tt * 16;
        __syncthreads();
#pragma unroll
        for (int it_ = 0; it_ < 2; ++it_) { const int e = tid + it_ * 512;
            if (e < 16 * 52) {
                const int tk = e / 52, col = (e - tk * 52) * 8, t = t0 + tk, tl = t & (SEQ - 1), sc = 1536 + col;
                const u32x4 uu = *(const u32x4*)(P.urw + (size_t)t * 1952 + sc);
                u32x4 pp = {0u, 0u, 0u, 0u}, nn = pp;
                if (tl > 0) pp = *(const u32x4*)(P.urw + (size_t)(t - 1) * 1952 + sc);
                if (tl < SEQ - 1) nn = *(const u32x4*)(P.urw + (size_t)(t + 1) * 1952 + sc);
                const float4 m0a = *(const float4*)(P.mu + sc), m0b = *(const float4*)(P.mu + sc + 4), m1a = *(const float4*)(P.mu + 1952 + sc), m1b = *(const float4*)(P.mu + 1952 + sc + 4);
                const float u8[8] = {bflo(uu.x), bfhi(uu.x), bflo(uu.y), bfhi(uu.y), bflo(uu.z), bfhi(uu.z), bflo(uu.w), bfhi(uu.w)};
                const float p8[8] = {bflo(pp.x), bfhi(pp.x), bflo(pp.y), bfhi(pp.y), bflo(pp.z), bfhi(pp.z), bflo(pp.w), bfhi(pp.w)};
                const float n8[8] = {bflo(nn.x), bfhi(nn.x), bflo(nn.y), bfhi(nn.y), bflo(nn.z), bfhi(nn.z), bflo(nn.w), bfhi(nn.w)};
                const float m0[8] = {m0a.x, m0a.y, m0a.z, m0a.w, m0b.x, m0b.y, m0b.z, m0b.w}, m1[8] = {m1a.x, m1a.y, m1a.z, m1a.w, m1b.x, m1b.y, m1b.z, m1b.w};
                float x8[8];
#pragma unroll
                for (int i = 0; i < 8; ++i) { float x = u8[i] + m0[i] * (p8[i] - u8[i]) + m1[i] * (n8[i] - u8[i]);
                    if (col < 128) { const float e2 = __expf(2.f * x); x = 1.f - 2.f * __builtin_amdgcn_rcpf(e2 + 1.f); } else if (col >= 256) x = sigm(x);
                    x8[i] = x; }
                u32x4 w; w.x = pk2(x8[0], x8[1]); w.y = pk2(x8[2], x8[3]); w.z = pk2(x8[4], x8[5]); w.w = pk2(x8[6], x8[7]);
                *(LAS u32x4*)(At + tk * 424 + col) = w;
            }
        }
        __syncthreads();
        const int t = t0 + fr, tl = t & (SEQ - 1);
#define AFR(ks) (*(const LAS bf16x8*)(At + fr * 424 + (ks) * 32 + fq * 8))
        float bon = 0.f;
#pragma unroll 1
        for (int pp = 0; pp < 2; ++pp) {
            const int c8 = hw * 64 + pp * 32 + 8 * fq;
            const int ncol0 = hw * 64 + pp * 32 + 8 * (fr >> 2) + (fr & 3), ncol1 = ncol0 + 4;
            f32x4 cwf0 = {0.f, 0.f, 0.f, 0.f}, cwb0 = cwf0, caf0 = cwf0, cab0 = cwf0, cg0 = cwf0, cwf1 = cwf0, cwb1 = cwf0, caf1 = cwf0, cab1 = cwf0, cg1 = cwf0;
#pragma unroll
            for (int kk2 = 0; kk2 < 2; ++kk2) { const int ko = kk2 * 32 + fq * 8;
                cwf0 = __builtin_amdgcn_mfma_f32_16x16x32_bf16(*(const bf16x8*)(P.w2t + (size_t)ncol0 * 64 + ko), AFR(0 + kk2), cwf0, 0, 0, 0);
                cwf1 = __builtin_amdgcn_mfma_f32_16x16x32_bf16(*(const bf16x8*)(P.w2t + (size_t)ncol1 * 64 + ko), AFR(0 + kk2), cwf1, 0, 0, 0);
                cwb0 = __builtin_amdgcn_mfma_f32_16x16x32_bf16(*(const bf16x8*)(P.w2t + (size_t)(512 + ncol0) * 64 + ko), AFR(2 + kk2), cwb0, 0, 0, 0);
                cwb1 = __builtin_amdgcn_mfma_f32_16x16x32_bf16(*(const bf16x8*)(P.w2t + (size_t)(512 + ncol1) * 64 + ko), AFR(2 + kk2), cwb1, 0, 0, 0);
                caf0 = __builtin_amdgcn_mfma_f32_16x16x32_bf16(*(const bf16x8*)(P.a2t + (size_t)ncol0 * 64 + ko), AFR(4 + kk2), caf0, 0, 0, 0);
                caf1 = __builtin_amdgcn_mfma_f32_16x16x32_bf16(*(const bf16x8*)(P.a2t + (size_t)ncol1 * 64 + ko), AFR(4 + kk2), caf1, 0, 0, 0);
                cab0 = __builtin_amdgcn_mfma_f32_16x16x32_bf16(*(const bf16x8*)(P.a2t + (size_t)(512 + ncol0) * 64 + ko), AFR(6 + kk2), cab0, 0, 0, 0);
                cab1 = __builtin_amdgcn_mfma_f32_16x16x32_bf16(*(const bf16x8*)(P.a2t + (size_t)(512 + ncol1) * 64 + ko), AFR(6 + kk2), cab1, 0, 0, 0);
            }
#pragma unroll
            for (int kk5 = 0; kk5 < 5; ++kk5) { const int ko = kk5 * 32 + fq * 8;
                cg0 = __builtin_amdgcn_mfma_f32_16x16x32_bf16(*(const bf16x8*)(P.g2t + (size_t)ncol0 * 160 + ko), AFR(8 + kk5), cg0, 0, 0, 0);
                cg1 = __builtin_amdgcn_mfma_f32_16x16x32_bf16(*(const bf16x8*)(P.g2t + (size_t)ncol1 * 160 + ko), AFR(8 + kk5), cg1, 0, 0, 0); }
            float rr[8], kv[8], vv[8];
            shift8(P.urw, t, tl, c8, P.mu, rr); shift8(P.urw, t, tl, 512 + c8, P.mu, kv); shift8(P.urw, t, tl, 1024 + c8, P.mu, vv);
            float w0f_[8], w0b_[8], a0f_[8], a0b_[8], ka_[8], rk_[8];
            ld8f(P.w0 + c8, w0f_); ld8f(P.w0 + 512 + c8, w0b_); ld8f(P.a0 + c8, a0f_); ld8f(P.a0 + 512 + c8, a0b_); ld8f(P.k_a + c8, ka_); ld8f(P.r_k + c8, rk_);
            const float xwf[8] = {cwf0[0], cwf0[1], cwf0[2], cwf0[3], cwf1[0], cwf1[1], cwf1[2], cwf1[3]}, xwb[8] = {cwb0[0], cwb0[1], cwb0[2], cwb0[3], cwb1[0], cwb1[1], cwb1[2], cwb1[3]};
            const float xaf[8] = {caf0[0], caf0[1], caf0[2], caf0[3], caf1[0], caf1[1], caf1[2], caf1[3]}, xab[8] = {cab0[0], cab0[1], cab0[2], cab0[3], cab1[0], cab1[1], cab1[2], cab1[3]};
            float lwf_[8], lwb_[8], aaf[8], aab[8];
#pragma unroll
            for (int j = 0; j < 8; ++j) {
                const float xf = w0f_[j] + xwf[j], xb = w0b_[j] + xwb[j];
                lwf_[j] = -__expf(-__logf(1.f + __expf(-xf)) - 0.5f); lwb_[j] = -__expf(-__logf(1.f + __expf(-xb)) - 0.5f);
                aaf[j] = sigm(a0f_[j] + xaf[j]); aab[j] = sigm(a0b_[j] + xab[j]);
                const float kdf = kv[j] * (1.f + (aaf[j] - 1.f) * ka_[j]), kdb = kv[j] * (1.f + (aab[j] - 1.f) * ka_[j]);
                bon += rr[j] * (kdf + kdb) * rk_[j];
            }
            const size_t off = (size_t)t * 512 + c8;
            st8bf(P.r + off, rr); st8bf(P.k + off, kv); st8bf(P.v + off, vv); st8bf(P.af + off, aaf); st8bf(P.ab + off, aab); st8bf(P.lwf + off, lwf_); st8bf(P.lwb + off, lwb_);
            { const float gg[8] = {cg0[0], cg0[1], cg0[2], cg0[3], cg1[0], cg1[1], cg1[2], cg1[3]}; st8bf(P.g + off, gg); }
        }
        bon += __shfl_xor(bon, 16); bon += __shfl_xor(bon, 32);
        if (fq == 0) P.bonus[(size_t)t * 8 + hw] = bon;
    }
}
__device__ __forceinline__ void scan_phase(LAS unsigned char* lds, const RwP P, bf16_t* yf, bf16_t* yb) {
    const int tid = TIDX(), cgx = tid & 15;
    for (int item = blockIdx.x; item < 256; item += gridDim.x) {
        const int half = item & 1, seq = item >> 1, dir = seq >> 6, b = (seq >> 3) & 7, h = seq & 7;
        const bf16_t* aA = dir ? P.ab : P.af; const bf16_t* lwA = dir ? P.lwb : P.lwf; bf16_t* yA = dir ? yb : yf;
        const float4 ka4 = *(const float4*)(P.k_a + h * 64 + cgx * 4), kkc4 = *(const float4*)(P.k_k + h * 64 + cgx * 4);
        __syncthreads();
#define SC_STAGE(chunk, step_, buf) do { const int sidx_ = (chunk) * 32 + (step_); const int t_ = dir ? (SEQ - 1 - sidx_) : sidx_; const size_t off_ = ((size_t)(b * SEQ + t_)) * 512 + h * 64 + cgx * 4; \
        const u32x2 Lr = *(const u32x2*)(P.r + off_), Lk = *(const u32x2*)(P.k + off_), Lv = *(const u32x2*)(P.v + off_), La = *(const u32x2*)(aA + off_), Llw = *(const u32x2*)(lwA + off_); \
        LAS f32x4* base_ = (LAS f32x4*)(lds + (buf) * 49152 + (step_) * 1536); \
        const float4 r4 = make_float4(bflo(Lr.x), bfhi(Lr.x), bflo(Lr.y), bfhi(Lr.y)), k4 = make_float4(bflo(Lk.x), bfhi(Lk.x), bflo(Lk.y), bfhi(Lk.y)), v4 = make_float4(bflo(Lv.x), bfhi(Lv.x), bflo(Lv.y), bfhi(Lv.y)); \
        float4 kk4 = make_float4(k4.x * kkc4.x, k4.y * kkc4.y, k4.z * kkc4.z, k4.w * kkc4.w); \
        { const float kin_ = 1.f / fmaxf(sqrtf(row16_allsum(kk4.x * kk4.x + kk4.y * kk4.y + kk4.z * kk4.z + kk4.w * kk4.w)), 1e-12f); kk4.x *= kin_; kk4.y *= kin_; kk4.z *= kin_; kk4.w *= kin_; } \
        const float4 a4 = make_float4(bflo(La.x), bfhi(La.x), bflo(La.y), bfhi(La.y)), l4 = make_float4(bflo(Llw.x), bfhi(Llw.x), bflo(Llw.y), bfhi(Llw.y)); \
        base_[cgx] = (f32x4){__expf(l4.x), __expf(l4.y), __expf(l4.z), __expf(l4.w)}; \
        base_[16 + cgx] = (f32x4){kk4.x * a4.x, kk4.y * a4.y, kk4.z * a4.z, kk4.w * a4.w}; \
        base_[32 + cgx] = (f32x4){k4.x * (1.f + (a4.x - 1.f) * ka4.x), k4.y * (1.f + (a4.y - 1.f) * ka4.y), k4.z * (1.f + (a4.z - 1.f) * ka4.z), k4.w * (1.f + (a4.w - 1.f) * ka4.w)}; \
        base_[48 + cgx] = (f32x4){kk4.x, kk4.y, kk4.z, kk4.w}; base_[64 + cgx] = (f32x4){r4.x, r4.y, r4.z, r4.w}; base_[80 + cgx] = (f32x4){v4.x, v4.y, v4.z, v4.w}; } while (0)
#define SC_YSTORE(chunk, p_) do { const int st_ = (p_) >> 4, rq_ = (p_) & 15; const int sidx_ = (chunk) * 32 + st_; const int t_ = dir ? (SEQ - 1 - sidx_) : sidx_; \
        const LAS float* yb_ = (const LAS float*)(lds + 98304 + ((chunk) & 1) * 4096); \
        *(unsigned*)(yA + ((size_t)(b * SEQ + t_)) * 512 + h * 64 + half * 32 + 2 * rq_) = pk2(yb_[st_ * 32 + 2 * rq_], yb_[st_ * 32 + 2 * rq_ + 1]); } while (0)
        { const int st0_ = tid >> 4; SC_STAGE(0, st0_, 0); }
        __syncthreads();
        const int rp = tid >> 4;
        const int ls = (tid - 256) >> 4;
        f32x2 a01 = {0.f, 0.f}, a23 = a01, b01 = a01, b23 = a01;
        for (int c = 0; c < 128; ++c) {
            const LAS unsigned char* vb = lds + (c & 1) * 49152;
            LAS float* ybuf = (LAS float*)(lds + 98304 + (c & 1) * 4096);
            if (tid < 256) {
                __builtin_amdgcn_s_setprio(3);
#define SC_LOAD(W, QK, DK, KK, R, VV, st_) do { const LAS f32x4* p_ = (const LAS f32x4*)(vb + (st_) * 1536); W = p_[cgx]; QK = p_[16 + cgx]; DK = p_[32 + cgx]; KK = p_[48 + cgx]; R = p_[64 + cgx]; \
        VV = *(const LAS f32x2*)(vb + (st_) * 1536 + (320 + half * 32 + 2 * rp) * 4); } while (0)
#define SC_STEP(W, QK, DK, KK, R, VV, st_) do { \
        f32x2 pa = a01 * KK.xy + a23 * KK.zw, pb = b01 * KK.xy + b23 * KK.zw; \
        float pza = pa.x + pa.y, pzb = pb.x + pb.y; \
        float z_ = zk + dpp_f<0x128>(zs);                   \
        pza += dpp_f<0x128>(pza); pzb += dpp_f<0x128>(pzb); z_ += dpp_f<0xB1>(z_); \
        pza += dpp_f<0x124>(pza); pzb += dpp_f<0x124>(pzb); z_ += dpp_f<0x4E>(z_); \
        pza += dpp_f<0x122>(pza); pzb += dpp_f<0x122>(pzb); z_ += dpp_f<0x141>(z_); \
        pza += dpp_f<0x121>(pza); pzb += dpp_f<0x121>(pzb); \
        ydst[((st_) > 0 ? (st_) - 1 : 0) * 32] = z_;                        \
        f32x2 sa2; sa2.x = -pza; sa2.y = -pza; f32x2 sb2; sb2.x = -pzb; sb2.y = -pzb; \
        f32x2 va; va.x = VV.x; va.y = VV.x; f32x2 vb2; vb2.x = VV.y; vb2.y = VV.y; \
        a01 = a01 * W.xy + sa2 * QK.xy + va * DK.xy; a23 = a23 * W.zw + sa2 * QK.zw + va * DK.zw; \
        b01 = b01 * W.xy + sb2 * QK.xy + vb2 * DK.xy; b23 = b23 * W.zw + sb2 * QK.zw + vb2 * DK.zw; \
        f32x2 ya = a01 * R.xy + a23 * R.zw, yb2 = b01 * R.xy + b23 * R.zw; \
        const float y0 = ya.x + ya.y, y1 = yb2.x + yb2.y; \
        zk = yhi ? y1 : y0; zs = yhi ? y0 : y1; } while (0)
                const bool yhi = (cgx & 8) != 0;
                LAS float* ydst = ((cgx & 7) == 0) ? (ybuf + 2 * rp + (yhi ? 1 : 0)) : ((LAS float*)(lds + 106496) + tid);
                float zk = 0.f, zs = 0.f;
                f32x4 w0, q0, d0, k0, r0, w1, q1, d1, k1, r1, w2, q2, d2, k2, r2, w3, q3, d3, k3, r3; f32x2 v0, v1, v2, v3;
                SC_LOAD(w0, q0, d0, k0, r0, v0, 0); SC_LOAD(w1, q1, d1, k1, r1, v1, 1); SC_LOAD(w2, q2, d2, k2, r2, v2, 2);
#pragma unroll
                for (int st = 0; st < 32; st += 4) {
                    SC_LOAD(w3, q3, d3, k3, r3, v3, st + 3);
                    SC_STEP(w0, q0, d0, k0, r0, v0, st);
                    SC_LOAD(w0, q0, d0, k0, r0, v0, st + 4);
                    SC_STEP(w1, q1, d1, k1, r1, v1, st + 1);
                    SC_LOAD(w1, q1, d1, k1, r1, v1, st + 5);
                    SC_STEP(w2, q2, d2, k2, r2, v2, st + 2);
                    SC_LOAD(w2, q2, d2, k2, r2, v2, st + 6);
                    SC_STEP(w3, q3, d3, k3, r3, v3, st + 3);
                }
                { float z_ = zk + dpp_f<0x128>(zs); z_ += dpp_f<0xB1>(z_); z_ += dpp_f<0x4E>(z_); z_ += dpp_f<0x141>(z_); ydst[31 * 32] = z_; }
#undef SC_LOAD
#undef SC_STEP
                __builtin_amdgcn_s_setprio(0);
            } else {
                if (c + 1 < 128) { SC_STAGE(c + 1, ls, (c + 1) & 1); SC_STAGE(c + 1, ls + 16, (c + 1) & 1); }
                if (c > 0) { SC_YSTORE(c - 1, tid - 256); SC_YSTORE(c - 1, tid); }
            }
            __syncthreads();
        }
        if (tid >= 256) { SC_YSTORE(127, tid - 256); SC_YSTORE(127, tid); }
#undef SC_STAGE
#undef SC_YSTORE
    }
}
__device__ __forceinline__ void rwpost_phase(const bf16_t* __restrict__ yf, const bf16_t* __restrict__ yb, const bf16_t* __restrict__ v, const bf16_t* __restrict__ g, const float* __restrict__ bonus, const float* __restrict__ ln_w, const float* __restrict__ ln_b, bf16_t* __restrict__ Acat) {
    const int lane = TIDX() & 63, wid = TIDX() >> 6;
#pragma unroll 4
    for (int t = blockIdx.x * 8 + wid; t < T; t += gridDim.x * 8) {
        const size_t off = (size_t)t * 512 + lane * 8;
        const u32x4 a4 = *(const u32x4*)(yf + off), b4 = *(const u32x4*)(yb + off), v4 = *(const u32x4*)(v + off), g4 = *(const u32x4*)(g + off);
        float y[8] = {bflo(a4.x) + bflo(b4.x), bfhi(a4.x) + bfhi(b4.x), bflo(a4.y) + bflo(b4.y), bfhi(a4.y) + bfhi(b4.y), bflo(a4.z) + bflo(b4.z), bfhi(a4.z) + bfhi(b4.z), bflo(a4.w) + bflo(b4.w), bfhi(a4.w) + bfhi(b4.w)};
        const float vv[8] = {bflo(v4.x), bfhi(v4.x), bflo(v4.y), bfhi(v4.y), bflo(v4.z), bfhi(v4.z), bflo(v4.w), bfhi(v4.w)};
        const float gg[8] = {bflo(g4.x), bfhi(g4.x), bflo(g4.y), bfhi(g4.y), bflo(g4.z), bfhi(g4.z), bflo(g4.w), bfhi(g4.w)};
        float s = 0.f;
#pragma unroll
        for (int i = 0; i < 8; ++i) s += y[i];
        s += __shfl_xor(s, 1); s += __shfl_xor(s, 2); s += __shfl_xor(s, 4);
        const float mean = s * (1.f / 64.f); float q = 0.f;
#pragma unroll
        for (int i = 0; i < 8; ++i) { y[i] -= mean; q += y[i] * y[i]; }
        q += __shfl_xor(q, 1); q += __shfl_xor(q, 2); q += __shfl_xor(q, 4);
        const float rstd = rsqrtf(q * (1.f / 64.f) + 64e-5f);
        const float bon = bonus[(size_t)t * 8 + (lane >> 3)];
        float o[8];
#pragma unroll
        for (int i = 0; i < 8; ++i) { const int c = lane * 8 + i; o[i] = ((y[i] * rstd) * ln_w[c] + ln_b[c] + bon * vv[i]) * gg[i]; }
        u32x4 w; w.x = pk2(o[0], o[1]); w.y = pk2(o[2], o[3]); w.z = pk2(o[4], o[5]); w.w = pk2(o[6], o[7]);
        *(u32x4*)(Acat + (size_t)t * DM + 512 + lane * 8) = w;
    }
}
__device__ __forceinline__ void ztrans_phase(LAS unsigned char* lds, const bf16_t* zT, bf16_t* Acat, int ldo) {
    const int tid = TIDX();
    LAS bf16_t* tile = (LAS bf16_t*)lds;
    for (int it = blockIdx.x; it < 4096; it += gridDim.x) {
        const int c0 = (it & 7) * 64, t0 = (it >> 3) * 64;
        __syncthreads();
        { const int i = tid >> 3, j8 = tid & 7; const u32x4 v = *(const u32x4*)(zT + (size_t)(c0 + i) * T + t0 + j8 * 8); *(LAS u32x4*)(tile + i * 72 + j8 * 8) = v; }
        __syncthreads();
        { const int j = tid >> 3, i8 = tid & 7; unsigned short e[8];
#pragma unroll
          for (int q = 0; q < 8; ++q) e[q] = tile[(i8 * 8 + q) * 72 + j];
          u32x4 w; w.x = e[0] | ((unsigned)e[1] << 16); w.y = e[2] | ((unsigned)e[3] << 16); w.z = e[4] | ((unsigned)e[5] << 16); w.w = e[6] | ((unsigned)e[7] << 16);
          *(u32x4*)(Acat + (size_t)(t0 + j) * ldo + c0 + i8 * 8) = w; }
    }
}

#ifndef EXP_LDA
#define EXP_LDA 1024
#endif
#define XB_TMO      128
#define XB_XCNT(j)  (256  + 64 * (j))
#define XB_XSUB(j)  (1280 + 64 * (j))
#define XB_XGEN(j)  (2304 + 64 * (j))
#define XB_TOP      3328
#define XB_TOPGEN   3392
#define XCD_BAR_WORDS 3456
#define XB_SPIN_CAP (1u << 18)

__device__ __forceinline__ unsigned xb_ld(unsigned* p)              { return __hip_atomic_load(p, __ATOMIC_RELAXED, __HIP_MEMORY_SCOPE_AGENT); }
__device__ __forceinline__ unsigned xb_add(unsigned* p, unsigned v) { return __hip_atomic_fetch_add(p, v, __ATOMIC_RELAXED, __HIP_MEMORY_SCOPE_AGENT); }
__device__ __forceinline__ unsigned xb_xcc_id() { return (unsigned)__builtin_amdgcn_s_getreg((3 << 11) | 20) & 0xFu; }
#define XB_SPIN(cond, bar) do { unsigned _sp = 0; while (cond) { __builtin_amdgcn_s_sleep(1); \
    if ((++_sp & 255u) == 0u) { if (xb_ld(&(bar)[XB_TMO])) break; if (_sp > XB_SPIN_CAP) { atomicAdd(&(bar)[XB_TMO], 1u); break; } } } } while (0)

struct XcdBarrier {
    unsigned* bar; unsigned x;
    volatile LAS unsigned* st;
};

__device__ __forceinline__ XcdBarrier xcd_barrier_post(unsigned* bar, volatile LAS unsigned* st) {
    XcdBarrier b; b.bar = bar; b.x = xb_xcc_id(); b.st = st;
    if (threadIdx.x == 0) (void)xb_add(&bar[XB_XCNT(b.x)], 1u);
    return b;
}
__device__ __forceinline__ void xcd_barrier_complete(unsigned* bar, unsigned x, unsigned& nloc, unsigned& nx) {
    const unsigned G = gridDim.x * gridDim.y * gridDim.z;
    unsigned sum, cnt, mine, sp = 0u;
    for (;;) {
        sum = 0u; cnt = 0u; mine = 0u;
#pragma unroll
        for (unsigned j = 0; j < 16; ++j) { const unsigned c = xb_ld(&bar[XB_XCNT(j)]); sum += c; cnt += (c > 0u) ? 1u : 0u; mine = (j == x) ? c : mine; }
        if (sum == G) break;
        __builtin_amdgcn_s_sleep(1);
        if ((++sp & 255u) == 0u) { if (xb_ld(&bar[XB_TMO])) break; if (sp > XB_SPIN_CAP) { atomicAdd(&bar[XB_TMO], 1u); break; } }
    }
    nloc = mine > 0u ? mine : 1u; nx = cnt > 0u ? cnt : 1u;
}

__device__ __forceinline__ void xcd_barrier(const XcdBarrier& b) {
    asm volatile("s_waitcnt vmcnt(0)" ::: "memory");
    __syncthreads();
    if (threadIdx.x == 0) {
        unsigned* bar = b.bar;
        __builtin_amdgcn_s_waitcnt(0);
        unsigned nloc = b.st[0], nx = b.st[1];
        if (nloc == 0u) { xcd_barrier_complete(bar, b.x, nloc, nx); b.st[0] = nloc; b.st[1] = nx; }
        const unsigned old = xb_add(&bar[XB_XSUB(b.x)], 1u);
        const unsigned gen = old / nloc;
        if (old + 1u == (gen + 1u) * nloc) {
            __builtin_amdgcn_fence(__ATOMIC_RELEASE, "agent");
            asm volatile("s_waitcnt vmcnt(0)" ::: "memory");
            const unsigned og = xb_add(&bar[XB_TOP], 1u);
            const unsigned tg = og / nx;
            if (og + 1u == (tg + 1u) * nx) xb_add(&bar[XB_TOPGEN], 1u);
            else XB_SPIN(xb_ld(&bar[XB_TOPGEN]) == tg, bar);
            __builtin_amdgcn_fence(__ATOMIC_ACQUIRE, "agent");
            xb_add(&bar[XB_XGEN(b.x)], 1u);
            asm volatile("s_waitcnt vmcnt(0)" ::: "memory");
        } else {
            XB_SPIN(xb_ld(&bar[XB_XGEN(b.x)]) == gen, bar);
            __builtin_amdgcn_fence(__ATOMIC_ACQUIRE, "agent");
            asm volatile("s_waitcnt vmcnt(0)" ::: "memory");
        }
    }
    __syncthreads();
}


#define GSYNC() xcd_barrier(xbar)
template <class T_> __device__ __forceinline__ T_* GP(T_* p) { return (T_*)(__attribute__((address_space(1))) T_*)p; }
#define GETA() (&a_param)
#define WSP(T_, off) ((T_*)(GP(GETA()->ws) + (off)))
__device__ __forceinline__ RwP make_rwp(const Args* a) {
    unsigned char* ws = GP(a->ws); bf16_t* WB = (bf16_t*)(ws + OFF_WBF);
    RwP P; P.urw = (bf16_t*)(ws + OFF_URW); P.mu = GP(a->in[18]); P.w0 = GP(a->in[19]); P.a0 = GP(a->in[21]); P.k_k = GP(a->in[24]); P.k_a = GP(a->in[25]); P.r_k = GP(a->in[26]);
    P.w2t = WB + W_W2T; P.a2t = WB + W_A2T; P.g2t = WB + W_G2T;
    P.r = (bf16_t*)(ws + OFF_R); P.k = (bf16_t*)(ws + OFF_K); P.v = (bf16_t*)(ws + OFF_V); P.kk = (bf16_t*)(ws + OFF_KK); P.af = (bf16_t*)(ws + OFF_AF); P.ab = (bf16_t*)(ws + OFF_AB);
    P.lwf = (bf16_t*)(ws + OFF_LWF); P.lwb = (bf16_t*)(ws + OFF_LWB); P.g = (bf16_t*)(ws + OFF_G); P.bonus = (float*)(ws + OFF_BONUS);
    return P;
}
__global__ void __launch_bounds__(512, 2) mega(Args a_param) {
    extern __shared__ __attribute__((aligned(16))) unsigned char lds_raw[];
    LAS unsigned char* lds = (LAS unsigned char*)lds_raw;
    cg::grid_group grid = cg::this_grid();
    volatile LAS unsigned* xst = (volatile LAS unsigned*)(lds + (LDS_BYTES - 16));
    if (threadIdx.x == 0) { xst[0] = 0u; xst[1] = 0u; }
    __syncthreads();
    const XcdBarrier xbar = xcd_barrier_post((unsigned*)(GP(a_param.ws) + OFF_BAR), xst);
    if (gridDim.x > 100000) grid.sync();
#ifdef DBL_P0
    for (int rep_ = 0; rep_ < 2; ++rep_)
#endif
    { const Args* a = GETA(); bf16_t* WB = (bf16_t*)(GP(a->ws) + OFF_WBF);
      cvt_wT_tiled(lds, GP(a->in[2]), 5632, WB + W_GU1, 5632, 1024, [](int n) { return gu_col(n); });
      cvt_wT_tiled(lds, GP(a->in[3]), 1024, WB + W_D1, 1024, 2816, [](int n) { return n; });
      cvt_wT_tiled(lds, GP(a->in[5]), 5536, WB + W_INHY, 1536, 1024, [](int n) { return n; });
      cvt_wT_tiled(lds, GP(a->in[5]), 5536, WB + W_INRW, 2048, 1024, [](int n) { return n < 1952 ? 1536 + n : -1; });
      cvt_wT_tiled(lds, GP(a->in[5]), 5536, WB + W_GT, 2048, 1024, [](int n) { return 3488 + n; });
      cvt_wT_tiled(lds, GP(a->in[17]), 1024, WB + W_HY, 1024, 512, [](int n) { return n; });
      cvt_wT_tiled(lds, GP(a->in[29]), 1024, WB + W_RW, 1024, 512, [](int n) { return n; });
      cvt_wT_tiled(lds, GP(a->in[30]), 1024, WB + W_O, 1024, 1024, [](int n) { return n; });
      cvt_wT_tiled(lds, GP(a->in[32]), 5632, WB + W_GU2, 5632, 1024, [](int n) { return gu_col(n); });
      cvt_wT_tiled(lds, GP(a->in[33]), 1024, WB + W_D2, 1024, 2816, [](int n) { return n; });
      cvt_wT(GP(a->in[20]), 512, WB + W_W2T, 512, 64, [](int n) { return n; });
      cvt_wT(GP(a->in[20]) + 64 * 512, 512, WB + W_W2T + 512 * 64, 512, 64, [](int n) { return n; });
      cvt_wT(GP(a->in[22]), 512, WB + W_A2T, 512, 64, [](int n) { return n; });
      cvt_wT(GP(a->in[22]) + 64 * 512, 512, WB + W_A2T + 512 * 64, 512, 64, [](int n) { return n; });
      cvt_wT(GP(a->in[23]), 512, WB + W_G2T, 512, 160, [](int n) { return n; });
      __syncthreads();
      norm_rows_bf16(GP(a->in[0]), GP(a->in[1]), (bf16_t*)(GP(a->ws) + OFF_A));
#ifdef DBL_NORM
      norm_rows_bf16(GP(a->in[0]), GP(a->in[1]), (bf16_t*)(GP(a->ws) + OFF_A));
#endif
#ifndef NO_MLP
      hy_mlp_phase(lds, GP(a->in[8]), GP(a->in[9]), GP(a->in[10]), GP(a->in[11]), GP(a->in[14]), (float*)(GP(a->ws) + OFF_MLP));
#endif
    }
    GSYNC();
    { const Args* a = GETA();
#ifndef NO_KRAW
      hy_kraw_phase(lds, GP(a->in[12]), GP(a->in[13]), GP(a->in[15]), (const float*)(GP(a->ws) + OFF_MLP), (float*)(GP(a->ws) + OFF_KRAW));
#ifdef DBL_KRAW
      hy_kraw_phase(lds, GP(a->in[12]), GP(a->in[13]), GP(a->in[15]), (const float*)(GP(a->ws) + OFF_MLP), (float*)(GP(a->ws) + OFF_KRAW));
#endif
#endif
      __syncthreads();
      EpiGU E; E.O = (bf16_t*)(GP(a->ws) + OFF_B);
      run_gemm(lds, (const bf16_t*)(GP(a->ws) + OFF_A), 1024, (const bf16_t*)(GP(a->ws) + OFF_WBF) + W_GU1, 1024, T, 5632, 1024, E);
#ifdef DBL_GU
      run_gemm(lds, (const bf16_t*)(GP(a->ws) + OFF_A), 1024, (const bf16_t*)(GP(a->ws) + OFF_WBF) + W_GU1, 1024, T, 5632, 1024, E);
#endif
      }
    GSYNC();
    { const Args* a = GETA();
      EpiResidT<0, 1> E; E.base = GP(a->in[0]); E.out = GP(a->out); E.scale = 0.5f;
      run_gemm(lds, (const bf16_t*)(GP(a->ws) + OFF_B), DFF, (const bf16_t*)(GP(a->ws) + OFF_WBF) + W_D1, DFF, T, 1024, DFF, E);
      __syncthreads();
#ifndef NO_FFT
      hy_filter_fft_phase(lds, (const float*)(GP(a->ws) + OFF_KRAW), (f32x2*)(GP(a->ws) + OFF_KF));
#ifdef DBL_FFT
      hy_filter_fft_phase(lds, (const float*)(GP(a->ws) + OFF_KRAW), (f32x2*)(GP(a->ws) + OFF_KF));
#endif
#endif
    }
    GSYNC();
#ifndef SKIP_MIXER
    { const Args* a = GETA(); norm_rows_bf16in((const bf16_t*)GP(a->out), GP(a->in[4]), (bf16_t*)(GP(a->ws) + OFF_A)); }
#ifdef DBL_NORM
    { const Args* a = GETA(); norm_rows_bf16in((const bf16_t*)GP(a->out), GP(a->in[4]), (bf16_t*)(GP(a->ws) + OFF_A)); }
#endif
    GSYNC();
    { const Args* a = GETA();
      EpiBf16<0> E1; E1.O = (bf16_t*)(GP(a->ws) + OFF_UTHY); E1.ldc = T; E1.ncols = T;
      run_gemm(lds, (const bf16_t*)(GP(a->ws) + OFF_WBF) + W_INHY, 1024, (const bf16_t*)(GP(a->ws) + OFF_A), 1024, 1536, T, 1024, E1); }
#ifndef EXP_SKIP_G3B
    { const Args* a = GETA();
      EpiBf16<0> E2; E2.O = (bf16_t*)(GP(a->ws) + OFF_URW); E2.ldc = 1952; E2.ncols = 1952;
      run_gemm(lds, (const bf16_t*)(GP(a->ws) + OFF_A), 1024, (const bf16_t*)(GP(a->ws) + OFF_WBF) + W_INRW, 1024, T, 2048, 1024, E2); }
#endif
    GSYNC();
#ifdef EXP8
    { const Args* a = GETA(); const bf16_t* uT_ = (const bf16_t*)(GP(a->ws) + OFF_UTHY); float* X_ = GP(a->out);
      for (size_t i = (size_t)blockIdx.x * 512 + TIDX(); i < (size_t)1024 * T; i += (size_t)gridDim.x * 512) { const size_t c = i / T, t = i % T; X_[t * DM + c] += bf2f(uT_[i]); } }
    GSYNC();
#else
#ifndef NO_HY

#ifndef SKIP_HY
#ifdef HY_TRIVIAL
    { const Args* a = GETA(); hyena_trivial((const bf16_t*)(GP(a->ws) + OFF_UTHY), (bf16_t*)(GP(a->ws) + OFF_ZT)); }
#else
    { const Args* a = GETA(); hyena_phase(lds, (const bf16_t*)(GP(a->ws) + OFF_UTHY), (const f32x2*)(GP(a->ws) + OFF_KF), GP(a->in[6]), GP(a->in[7]), GP(a->in[16]), (bf16_t*)(GP(a->ws) + OFF_ZT)); }
#ifdef DBL_HY
    { const Args* a = GETA(); hyena_phase(lds, (const bf16_t*)(GP(a->ws) + OFF_UTHY), (const f32x2*)(GP(a->ws) + OFF_KF), GP(a->in[6]), GP(a->in[7]), GP(a->in[16]), (bf16_t*)(GP(a->ws) + OFF_ZT)); }
#endif
#endif
#endif

#endif
    GSYNC();
#ifndef NO_PREP

#ifndef SKIP_RW
    { const Args* a = GETA(); rwprep_phase(lds, make_rwp(a)); }
#ifdef DBL_PREP
    { const Args* a = GETA(); rwprep_phase(lds, make_rwp(a)); }
#endif
#endif

#endif
    GSYNC();
#ifndef NO_SCAN

#ifndef SKIP_RW
    { const Args* a = GETA(); scan_phase(lds, make_rwp(a), (bf16_t*)(GP(a->ws) + OFF_YF), (bf16_t*)(GP(a->ws) + OFF_YB)); }
#ifdef DBL_SCAN
    { const Args* a = GETA(); scan_phase(lds, make_rwp(a), (bf16_t*)(GP(a->ws) + OFF_YF), (bf16_t*)(GP(a->ws) + OFF_YB)); }
#endif
#endif

#endif
    GSYNC();
    { const Args* a = GETA(); unsigned char* ws = GP(a->ws);

#ifndef SKIP_RW
      rwpost_phase((const bf16_t*)(ws + OFF_YF), (const bf16_t*)(ws + OFF_YB), (const bf16_t*)(ws + OFF_V), (const bf16_t*)(ws + OFF_G), (const float*)(ws + OFF_BONUS), GP(a->in[27]), GP(a->in[28]), (bf16_t*)(ws + OFF_ACAT));
#endif


#ifndef SKIP_HY
      ztrans_phase(lds, (const bf16_t*)(ws + OFF_ZT), (bf16_t*)(ws + OFF_ACAT), EXP_LDA);
#endif

#ifndef EXP4
      norm_rows_bf16in((const bf16_t*)GP(a->out), GP(a->in[4]), (bf16_t*)(ws + OFF_A));
#ifdef DBL_NORM
      norm_rows_bf16in((const bf16_t*)GP(a->out), GP(a->in[4]), (bf16_t*)(ws + OFF_A));
#endif
#endif
      }
    GSYNC();
#if !defined(EXP2) && !defined(EXP3)
    { const Args* a = GETA(); EpiBf16<1> E; E.O = (bf16_t*)(GP(a->ws) + OFF_GATES); E.ldc = 2048; E.ncols = 2048;
      run_gemm(lds, (const bf16_t*)(GP(a->ws) + OFF_A), 1024, (const bf16_t*)(GP(a->ws) + OFF_WBF) + W_GT, 1024, T, 2048, 1024, E); }
#endif
    GSYNC();
    { const Args* a = GETA(); EpiMerge<0> E; E.Mg = (bf16_t*)(GP(a->ws) + OFF_MERGED); E.gates = (const bf16_t*)(GP(a->ws) + OFF_GATES); E.goff = 0;
      run_gemm(lds, (const bf16_t*)(GP(a->ws) + OFF_ACAT), 1024, (const bf16_t*)(GP(a->ws) + OFF_WBF) + W_HY, 512, T, 1024, 512, E); }
    GSYNC();
    { const Args* a = GETA(); EpiMerge<1> E; E.Mg = (bf16_t*)(GP(a->ws) + OFF_MERGED); E.gates = (const bf16_t*)(GP(a->ws) + OFF_GATES); E.goff = 1024;
      run_gemm(lds, (const bf16_t*)(GP(a->ws) + OFF_ACAT) + 512, 1024, (const bf16_t*)(GP(a->ws) + OFF_WBF) + W_RW, 512, T, 1024, 512, E); }
    GSYNC();
    { const Args* a = GETA(); EpiResidT<1, 1> E; E.base = GP(a->out); E.out = GP(a->out); E.scale = 1.f;
      run_gemm(lds, (const bf16_t*)(GP(a->ws) + OFF_MERGED), 1024, (const bf16_t*)(GP(a->ws) + OFF_WBF) + W_O, 1024, T, 1024, 1024, E); }
    GSYNC();
#endif
#endif
    { const Args* a = GETA(); norm_rows_bf16in((const bf16_t*)GP(a->out), GP(a->in[31]), (bf16_t*)(GP(a->ws) + OFF_A)); }
#ifdef DBL_NORM
    { const Args* a = GETA(); norm_rows_bf16in((const bf16_t*)GP(a->out), GP(a->in[31]), (bf16_t*)(GP(a->ws) + OFF_A)); }
#endif
    GSYNC();
    { const Args* a = GETA(); EpiGU E; E.O = (bf16_t*)(GP(a->ws) + OFF_B);
      run_gemm(lds, (const bf16_t*)(GP(a->ws) + OFF_A), 1024, (const bf16_t*)(GP(a->ws) + OFF_WBF) + W_GU2, 1024, T, 5632, 1024, E); }
    GSYNC();
    { const Args* a = GETA(); EpiResidT<1, 1> E; E.base = GP(a->out); E.out = (bf16_t*)(GP(a->ws) + OFF_X3); E.scale = 0.5f;
      run_gemm(lds, (const bf16_t*)(GP(a->ws) + OFF_B), DFF, (const bf16_t*)(GP(a->ws) + OFF_WBF) + W_D2, DFF, T, 1024, DFF, E); }
    GSYNC();
#ifdef EXTRA_SYNCS
    for (int r_ = 0; r_ < 10; ++r_) { GSYNC(); }
#endif
    { const Args* a = GETA(); norm_rows_bf16_to_f32((const bf16_t*)(GP(a->ws) + OFF_X3), GP(a->in[34]), GP(a->out)); }
}

extern "C" void kernel_launch(void* const* d_in, const int* in_sizes, int n_in, void* d_out, int out_size, void* d_ws, size_t ws_size, hipStream_t stream) {
    static int grid = 0;
    if (grid == 0) {
        int dev = 0, cus = 0, per_cu = 0;
        (void)hipGetDevice(&dev); (void)hipDeviceGetAttribute(&cus, hipDeviceAttributeMultiprocessorCount, dev);
        (void)hipFuncSetAttribute((const void*)mega, hipFuncAttributeMaxDynamicSharedMemorySize, LDS_BYTES);
        (void)hipOccupancyMaxActiveBlocksPerMultiprocessor(&per_cu, (const void*)mega, 512, LDS_BYTES);
        (void)hipGetLastError();
        grid = cus > 0 ? cus : 256;
        if (n_in != 35 || ws_size < 512 * MiB) fprintf(stderr, "kernel_launch: unexpected n_in %d / ws %zu\n", n_in, ws_size);
    }
    (void)hipMemsetAsync((unsigned char*)d_ws + OFF_BAR, 0, XCD_BAR_WORDS * 4, stream);
    Args a{};
    for (int i = 0; i < 35; ++i) a.in[i] = (const float*)d_in[i];
    a.out = (float*)d_out; a.ws = (unsigned char*)d_ws;
    void* args[] = {&a};
    hipError_t e = hipLaunchCooperativeKernel((const void*)mega, dim3(grid), dim3(512), args, LDS_BYTES, stream);
    if (e != hipSuccess) fprintf(stderr, "cooperative launch failed: %s (grid %d)\n", hipGetErrorString(e), grid);
}
```
